# Optimizing an MI355X kernel written in HIP

```python
import math
import jax, jax.numpy as jnp
from jax import lax
import numpy as np

D_MODEL = 1024
BATCH = 8
SEQ = 2048
DEPTH = 1

D_MIX = D_MODEL
D_MLSTM = D_MIX // 2
N_MLSTM_HEADS = 4
MLSTM_HEAD_DIM = D_MLSTM // N_MLSTM_HEADS
MLSTM_CHUNK = 64
CONV_WIDTH = 4
D_S5 = D_MIX - D_MLSTM
S5_GROUP = 16
N_S5_GROUPS = D_S5 // S5_GROUP
S5_STATE = 64
D_FF = -(-8 * D_MODEL // (3 * 256)) * 256
D_IN = 4 * D_MLSTM + 2 * N_MLSTM_HEADS + D_S5
EPS = 1e-6

kernel_name = 'hymba_mlstm_s5_hybrid_block'


def rmsnorm(x, g):
    xf = x.astype(jnp.float32)
    y = xf * lax.rsqrt(jnp.mean(xf * xf, axis=-1, keepdims=True) + EPS)
    return (y * g.astype(jnp.float32)).astype(x.dtype)


def causal_depthwise_conv(x, w):
    K, C = w.shape
    return lax.conv_general_dilated(x, w[:, None, :].astype(x.dtype), window_strides=(1,), padding=[(K - 1, 0)], dimension_numbers=('NWC', 'WIO', 'NWC'), feature_group_count=C)


def mlstm_chunkwise(q, k, v, log_i, log_f):
    Bsz, H, S, Dh = q.shape
    L = MLSTM_CHUNK
    NC = S // L
    q = q.astype(jnp.float32).reshape(Bsz, H, NC, L, Dh)
    k = k.astype(jnp.float32).reshape(Bsz, H, NC, L, Dh)
    v = v.astype(jnp.float32).reshape(Bsz, H, NC, L, Dh)
    li = log_i.astype(jnp.float32).reshape(Bsz, H, NC, L)
    lf = log_f.astype(jnp.float32).reshape(Bsz, H, NC, L)
    b = jnp.cumsum(lf, axis=-1)
    b_last = b[..., -1]
    w_state = b_last[..., None] - b + li
    m_loc = jnp.max(w_state, axis=-1)
    e = jnp.exp(w_state - m_loc[..., None])
    C_loc = jnp.einsum('bhcsk,bhcsv->bhckv', e[..., None] * k, v)
    n_loc = jnp.einsum('bhcs,bhcsk->bhck', e, k)

    def step(carry, inp):
        C, n, m = carry
        Cl, nl, ml, bl = inp
        m_new = jnp.maximum(bl + m, ml)
        a = jnp.exp(bl + m - m_new)
        c = jnp.exp(ml - m_new)
        C_new = a[..., None, None] * C + c[..., None, None] * Cl
        n_new = a[..., None] * n + c[..., None] * nl
        return (C_new, n_new, m_new), (C, n, m)

    init = (jnp.zeros((Bsz, H, Dh, Dh), jnp.float32), jnp.zeros((Bsz, H, Dh), jnp.float32), jnp.zeros((Bsz, H), jnp.float32))
    xs = (jnp.moveaxis(C_loc, 2, 0), jnp.moveaxis(n_loc, 2, 0), jnp.moveaxis(m_loc, 2, 0), jnp.moveaxis(b_last, 2, 0))
    _, (C_prev, n_prev, m_prev) = lax.scan(step, init, xs)
    C_prev = jnp.moveaxis(C_prev, 0, 2)
    n_prev = jnp.moveaxis(n_prev, 0, 2)
    m_prev = jnp.moveaxis(m_prev, 0, 2)

    log_inter = b + m_prev[..., None]
    causal = jnp.tril(jnp.ones((L, L), dtype=bool))
    D = b[..., :, None] - b[..., None, :] + li[..., None, :]
    D = jnp.where(causal, D, -jnp.inf)
    m_t = jnp.maximum(log_inter, jnp.max(D, axis=-1))
    inter_w = jnp.exp(log_inter - m_t)
    P = jnp.exp(D - m_t[..., None]) * jnp.einsum('bhctd,bhcsd->bhcts', q, k)
    num = inter_w[..., None] * jnp.einsum('bhctk,bhckv->bhctv', q, C_prev) + jnp.einsum('bhcts,bhcsv->bhctv', P, v)
    den = inter_w * jnp.einsum('bhctk,bhck->bhct', q, n_prev) + jnp.sum(P, axis=-1)
    h = num / jnp.maximum(jnp.abs(den), jnp.exp(-m_t))[..., None]
    return h.reshape(Bsz, H, S, Dh)


def s5_ssm(u, a_re, a_im, log_dt, b_re, b_im, c_re, c_im, d_skip):
    Bsz, S, _ = u.shape
    f32 = jnp.float32
    uf = u.astype(f32).reshape(Bsz, S, N_S5_GROUPS, S5_GROUP)
    a_re = a_re.astype(f32); a_im = a_im.astype(f32)
    dt = jnp.exp(log_dt.astype(f32))[:, None]
    mag = jnp.exp(dt * a_re)
    ang = dt * a_im
    ab_re = mag * jnp.cos(ang)
    ab_im = mag * jnp.sin(ang)
    den = a_re * a_re + a_im * a_im
    nr = ab_re - 1.0
    z_re = (nr * a_re + ab_im * a_im) / den
    z_im = (ab_im * a_re - nr * a_im) / den
    b_re = b_re.astype(f32); b_im = b_im.astype(f32)
    bb_re = z_re[..., None] * b_re - z_im[..., None] * b_im
    bb_im = z_re[..., None] * b_im + z_im[..., None] * b_re
    bu_re = jnp.einsum('bsgh,gph->sbgp', uf, bb_re)
    bu_im = jnp.einsum('bsgh,gph->sbgp', uf, bb_im)
    a_seq_re = jnp.broadcast_to(ab_re[None, None], (S, 1, N_S5_GROUPS, S5_STATE))
    a_seq_im = jnp.broadcast_to(ab_im[None, None], (S, 1, N_S5_GROUPS, S5_STATE))

    def combine(e1, e2):
        a1r, a1i, x1r, x1i = e1
        a2r, a2i, x2r, x2i = e2
        ar = a2r * a1r - a2i * a1i
        ai = a2r * a1i + a2i * a1r
        xr = a2r * x1r - a2i * x1i + x2r
        xi = a2r * x1i + a2i * x1r + x2i
        return ar, ai, xr, xi

    _, _, xr, xi = lax.associative_scan(combine, (a_seq_re, a_seq_im, bu_re, bu_im), axis=0)
    y = jnp.einsum('ghp,sbgp->bsgh', c_re.astype(f32), xr) - jnp.einsum('ghp,sbgp->bsgh', c_im.astype(f32), xi)
    y = y.reshape(Bsz, S, D_S5) + d_skip.astype(f32) * uf.reshape(Bsz, S, D_S5)
    return y


def setup_inputs(seed: int = 0) -> dict:
    key = jax.random.key(seed)
    ks = jax.random.split(key, 24)
    f32 = jnp.float32
    H = N_MLSTM_HEADS
    G = N_S5_GROUPS
    P = S5_STATE

    def nrm(k, shape, scale):
        return jax.random.normal(k, shape, f32) * scale

    x = nrm(ks[0], (BATCH, SEQ, D_MODEL), 1.0)
    norm1_g = 1.0 + nrm(ks[1], (DEPTH, D_MODEL), 0.02)
    w_in = nrm(ks[2], (DEPTH, D_MODEL, D_IN), D_MODEL ** -0.5)
    f_bias = jnp.linspace(3.0, 6.0, H, dtype=f32)
    if_bias = jnp.concatenate([nrm(ks[3], (DEPTH, H), 0.1), f_bias[None] + nrm(ks[4], (DEPTH, H), 0.01)], axis=-1)
    conv_qk = nrm(ks[5], (DEPTH, CONV_WIDTH, 2 * D_MLSTM), CONV_WIDTH ** -0.5)
    mlstm_norm_g = 1.0 + nrm(ks[6], (DEPTH, D_MLSTM), 0.02)
    n_idx = jnp.arange(P, dtype=f32)
    a_re = -0.5 + nrm(ks[7], (DEPTH, G, P), 0.01)
    a_im = math.pi * n_idx + nrm(ks[8], (DEPTH, G, P), 0.01)
    log_dt = jax.random.uniform(ks[9], (DEPTH, G), f32, math.log(1e-3), math.log(1e-1))
    b_re = nrm(ks[10], (DEPTH, G, P, S5_GROUP), (2 * S5_GROUP) ** -0.5)
    b_im = nrm(ks[11], (DEPTH, G, P, S5_GROUP), (2 * S5_GROUP) ** -0.5)
    c_re = nrm(ks[12], (DEPTH, G, S5_GROUP, P), P ** -0.5)
    c_im = nrm(ks[13], (DEPTH, G, S5_GROUP, P), P ** -0.5)
    d_skip = nrm(ks[14], (DEPTH, D_S5), 0.5)
    w_glu = nrm(ks[15], (DEPTH, D_S5, D_S5), D_S5 ** -0.5)
    b_glu = nrm(ks[16], (DEPTH, D_S5), 0.01)
    s5_norm_g = 1.0 + nrm(ks[17], (DEPTH, D_S5), 0.02)
    w_out = nrm(ks[18], (DEPTH, D_MIX, D_MODEL), D_MIX ** -0.5)
    norm2_g = 1.0 + nrm(ks[19], (DEPTH, D_MODEL), 0.02)
    w_gate = nrm(ks[20], (DEPTH, D_MODEL, D_FF), D_MODEL ** -0.5)
    w_up = nrm(ks[21], (DEPTH, D_MODEL, D_FF), D_MODEL ** -0.5)
    w_down = nrm(ks[22], (DEPTH, D_FF, D_MODEL), D_FF ** -0.5)
    norm_f_g = 1.0 + nrm(ks[23], (D_MODEL,), 0.02)
    return {'x': x, 'norm1_g': norm1_g, 'w_in': w_in, 'if_bias': if_bias, 'conv_qk': conv_qk, 'mlstm_norm_g': mlstm_norm_g, 'a_re': a_re, 'a_im': a_im, 'log_dt': log_dt, 'b_re': b_re, 'b_im': b_im, 'c_re': c_re, 'c_im': c_im, 'd_skip': d_skip, 'w_glu': w_glu, 'b_glu': b_glu, 's5_norm_g': s5_norm_g, 'w_out': w_out, 'norm2_g': norm2_g, 'w_gate': w_gate, 'w_up': w_up, 'w_down': w_down, 'norm_f_g': norm_f_g}


def reference(x, norm1_g, w_in, if_bias, conv_qk, mlstm_norm_g, a_re, a_im, log_dt, b_re, b_im, c_re, c_im, d_skip, w_glu, b_glu, s5_norm_g, w_out, norm2_g, w_gate, w_up, w_down, norm_f_g):
    Bsz, S, _ = x.shape
    H, Dh = N_MLSTM_HEADS, MLSTM_HEAD_DIM
    h = x
    for l in range(DEPTH):
        xn = rmsnorm(h, norm1_g[l])
        proj = xn @ w_in[l]
        qk = proj[..., :2 * D_MLSTM]
        v = proj[..., 2 * D_MLSTM:3 * D_MLSTM]
        o_pre = proj[..., 3 * D_MLSTM:4 * D_MLSTM]
        gates = (proj[..., 4 * D_MLSTM:4 * D_MLSTM + 2 * H] + if_bias[l]).astype(jnp.float32)
        u = proj[..., 4 * D_MLSTM + 2 * H:]

        qk = jax.nn.silu(causal_depthwise_conv(qk, conv_qk[l]))
        q = qk[..., :D_MLSTM].reshape(Bsz, S, H, Dh).transpose(0, 2, 1, 3)
        k = (qk[..., D_MLSTM:] * (Dh ** -0.5)).reshape(Bsz, S, H, Dh).transpose(0, 2, 1, 3)
        vh = v.reshape(Bsz, S, H, Dh).transpose(0, 2, 1, 3)
        log_i = gates[..., :H].transpose(0, 2, 1)
        log_f = jax.nn.log_sigmoid(gates[..., H:]).transpose(0, 2, 1)
        h_tilde = mlstm_chunkwise(q, k, vh, log_i, log_f).transpose(0, 2, 1, 3)
        hm = jax.nn.sigmoid(o_pre.astype(jnp.float32)).reshape(Bsz, S, H, Dh) * h_tilde
        mu = jnp.mean(hm, axis=-1, keepdims=True)
        var = jnp.mean(jnp.square(hm - mu), axis=-1, keepdims=True)
        hm = ((hm - mu) * lax.rsqrt(var + EPS)).reshape(Bsz, S, D_MLSTM) * mlstm_norm_g[l].astype(jnp.float32)

        y = s5_ssm(u, a_re[l], a_im[l], log_dt[l], b_re[l], b_im[l], c_re[l], c_im[l], d_skip[l])
        g = jax.nn.gelu(y)
        g = g * jax.nn.sigmoid(g @ w_glu[l].astype(jnp.float32) + b_glu[l].astype(jnp.float32))
        hs = rmsnorm(g, s5_norm_g[l])

        mixed = jnp.concatenate([hm.astype(x.dtype), hs.astype(x.dtype)], axis=-1)
        h = h + mixed @ w_out[l]

        xn2 = rmsnorm(h, norm2_g[l])
        h = h + (jax.nn.silu(xn2 @ w_gate[l]) * (xn2 @ w_up[l])) @ w_down[l]
    return rmsnorm(h, norm_f_g)
```

```cpp
#include <hip/hip_runtime.h>
#include <hip/hip_cooperative_groups.h>
#include <cstdio>
#include <cstdint>
#ifndef N_LAUNCHES
#define N_LAUNCHES 1
#endif
namespace pg8 {
#define PG8_LAS __attribute__((address_space(3)))
typedef unsigned short bf16_t;
typedef short bf16x8 __attribute__((ext_vector_type(8)));
typedef float f32x4 __attribute__((ext_vector_type(4)));
typedef unsigned u32x4 __attribute__((ext_vector_type(4)));
constexpr int BM = 256, BK = 64, HALF = 128, HTB = HALF * BK * 2  , STAGE_BYTES = 8 * HTB, NXCD = 8, WGM = 8;

__host__ __device__ __forceinline__ int lds_byte(int r, int c) { const int st = (r >> 4) * 2 + (c >> 5), rr = r & 15, cc = c & 31, ob = rr * 64 + cc * 2; return st * 1024 + (ob ^ (((ob >> 9) & 1) << 5)); }
__host__ __device__ __forceinline__ void stage_rc(int b, int& R, int& C) { const int st = b / 1024, sb = b % 1024, swz = sb ^ (((sb >> 9) & 1) << 5); R = (st >> 1) * 16 + swz / 64; C = (st & 1) * 32 + (swz % 64) / 2; }
__host__ __device__ __forceinline__ int perm32(int rho) { const int n = rho >> 4, i = rho & 15; return 8 * (i >> 2) + 4 * n + (i & 3); }

struct Unit { int pm, pn; };
struct Gemm { const bf16_t* A; const bf16_t* Bt; int M, N, K; };

struct StaticOrder {
    int nM, nN, nwg, G, c;
    __host__ __device__ void init(int M, int N, int G_, int c_) { nM = M / BM; nN = N / BM; nwg = nM * nN; G = G_; c = c_; }
    __host__ __device__ bool next(int i, Unit& u) const {
        const long L = (long)i * G + c; if (L >= nwg) return false;
        int wgid = (int)L; { const int q = nwg / NXCD, r = nwg % NXCD, xcd = wgid % NXCD, off = wgid / NXCD; wgid = (xcd < r ? xcd * (q + 1) : r * (q + 1) + (xcd - r) * q) + off; }
        const int nig = WGM * nN, gid = wgid / nig, fm = gid * WGM, gsz = (nM - fm) < WGM ? (nM - fm) : WGM;
        u.pm = fm + ((wgid % nig) % gsz); u.pn = (wgid % nig) / gsz; return true;
    }
    __device__ __forceinline__ void a_ready(const Unit&) const {}
    __device__ __forceinline__ void done(const Unit&) const {}
};

__device__ __forceinline__ unsigned cvt_pk_bf16(float lo, float hi) { unsigned r; asm volatile("v_cvt_pk_bf16_f32 %0, %1, %2" : "=v"(r) : "v"(lo), "v"(hi)); return r; }
typedef float f32x2 __attribute__((ext_vector_type(2)));
__device__ __forceinline__ f32x2 gelu_pk(f32x2 v) {
    const f32x2 av = __builtin_elementwise_abs(v), d = av * 0.2316418882f + 1.0f;
    f32x2 t; t.x = __builtin_amdgcn_rcpf(d.x); t.y = __builtin_amdgcn_rcpf(d.y);
    f32x2 q = t * 0.5307027145f + (-0.7265760135f); q = q * t + 0.7107068705f; q = q * t + (-0.142248368f); q = q * t + 0.127414796f; q = q * t;
    const f32x2 s = (v * v) * (-0.72134752044f);
    f32x2 e; e.x = __builtin_amdgcn_exp2f(s.x); e.y = __builtin_amdgcn_exp2f(s.y);
    const f32x2 m = v * (q * e), r = v - m;
    f32x2 o; o.x = v.x < 0.f ? m.x : r.x; o.y = v.y < 0.f ? m.y : r.y; return o;
}

template <int ACT  > struct EpiBf16 {
    static constexpr bool PERM = true, AFTER_DRAIN = false; static_assert(ACT == 0 || ACT == 1, "EpiBf16: ACT is 0 (none) or 1 (gelu_pk)");
    bf16_t* O; int ldc; const float* bias; int split_cols; size_t split_stride; float scale0;
    __device__ __forceinline__ void operator()(const f32x4 (&acc)[2][2][4][2], const Unit& u, int wr, int wc, int fr, int fq) const {
        const int row0 = u.pm * BM + wr * 64 + fr; int colt = u.pn * BM; bf16_t* base = O;
        float sc = 1.f; if (split_cols) { const int t = colt / split_cols; base += (size_t)t * split_stride; colt -= t * split_cols; if (t == 0) sc = scale0; }
        const int col0 = colt + wc * 32 + 8 * fq, bcol0 = u.pn * BM + wc * 32 + 8 * fq;
        f32x4 bv[2][2];
#pragma unroll
        for (int bj = 0; bj < 2; ++bj)
#pragma unroll
            for (int n = 0; n < 2; ++n) bv[bj][n] = bias ? *(const f32x4*)(bias + bcol0 + bj * HALF + 4 * n) : (f32x4){0.f, 0.f, 0.f, 0.f};
#pragma unroll
        for (int ai = 0; ai < 2; ++ai)
#pragma unroll
            for (int m = 0; m < 4; ++m) { bf16_t* rowp = base + (size_t)(row0 + ai * HALF + m * 16) * ldc + col0;
#pragma unroll
                for (int bj = 0; bj < 2; ++bj) { f32x4 v0 = acc[ai][bj][m][0] + bv[bj][0], v1 = acc[ai][bj][m][1] + bv[bj][1];
                    if (ACT == 1) { f32x2 a = gelu_pk((f32x2){v0[0], v0[1]}), b = gelu_pk((f32x2){v0[2], v0[3]}), c = gelu_pk((f32x2){v1[0], v1[1]}), d = gelu_pk((f32x2){v1[2], v1[3]});
                        v0 = (f32x4){a.x, a.y, b.x, b.y}; v1 = (f32x4){c.x, c.y, d.x, d.y}; }
                    v0 = v0 * sc; v1 = v1 * sc; u32x4 w; w.x = cvt_pk_bf16(v0[0], v0[1]); w.y = cvt_pk_bf16(v0[2], v0[3]); w.z = cvt_pk_bf16(v1[0], v1[1]); w.w = cvt_pk_bf16(v1[2], v1[3]);
                    *(u32x4*)(rowp + bj * HALF) = w; } }
    }
};
template <class Epi, class Sched, bool ALIGN_EPI = false, bool SP2 = false>
__device__ __forceinline__ void gemm_phase(PG8_LAS unsigned char* lds, const Gemm g, const Sched& S, const Epi& E) {
    const int tid = threadIdx.x, wid = __builtin_amdgcn_readfirstlane(tid >> 6), lane = tid & 63, wr = wid >> 2, wc = wid & 3, fr = lane & 15, fq = lane >> 4;
    const int K = g.K, nt = K / BK;
    unsigned voffA[2], voffB[2];
#pragma unroll
    for (int i = 0; i < 2; ++i) { int R, C; stage_rc(tid * 16 + i * 8192, R, C); const int Rb = Epi::PERM ? ((R & ~31) + perm32(R & 31)) : R;
        voffA[i] = (unsigned)(R * K + C) * 2u; voffB[i] = (unsigned)(Rb * K + C) * 2u; }
    const size_t kstep = (size_t)(BK * 2);
    const size_t hstep = (size_t)HALF * K * 2;
    const size_t tstep = 2 * hstep;
    const unsigned ldsw = (unsigned)wid * 1024u;
    const int aoff = lds_byte(wr * 64 + fr, fq * 8), boff = lds_byte(wc * 32 + fr, fq * 8);
#define PG8_SA(b, h) (((b) * 2 + (h)) * HTB)
#define PG8_SB(b, h) ((4 + (b) * 2 + (h)) * HTB)
#define PG8_STAGE(bufoff, gbase, voff) do { _Pragma("unroll") for (int _i = 0; _i < 2; ++_i) \
        __builtin_amdgcn_global_load_lds((const unsigned*)((const char*)(gbase) + (voff)[_i]), (PG8_LAS unsigned*)(lds + (bufoff) + ldsw + _i * 8192), 16, 0, 0); } while (0)
#define PG8_LDA(dst, b, h) do { _Pragma("unroll") for (int m = 0; m < 4; ++m) _Pragma("unroll") for (int k = 0; k < 2; ++k) dst[m][k] = *(const PG8_LAS bf16x8*)(lds + PG8_SA(b, h) + aoff + m * 2048 + k * 1024); } while (0)
#define PG8_LDB(dst, b, h) do { _Pragma("unroll") for (int n = 0; n < 2; ++n) _Pragma("unroll") for (int k = 0; k < 2; ++k) dst[n][k] = *(const PG8_LAS bf16x8*)(lds + PG8_SB(b, h) + boff + n * 2048 + k * 1024); } while (0)
#define PG8_MMA(ai, bj, At, Bt) do { __builtin_amdgcn_s_setprio(1); _Pragma("unroll") for (int m = 0; m < 4; ++m) _Pragma("unroll") for (int n = 0; n < 2; ++n) _Pragma("unroll") for (int k = 0; k < 2; ++k) \
        acc[ai][bj][m][n] = __builtin_amdgcn_mfma_f32_16x16x32_bf16(Bt[n][k], At[m][k], acc[ai][bj][m][n], 0, 0, 0); __builtin_amdgcn_s_setprio(0); } while (0)
#define PG8_WAIT_V(n) asm volatile("s_waitcnt vmcnt(" #n ")" ::: "memory")
#define PG8_WAIT_L(n) asm volatile("s_waitcnt lgkmcnt(" #n ")" ::: "memory")
#define PG8_BAR __builtin_amdgcn_s_barrier()
#define PG8_SCHED __builtin_amdgcn_sched_barrier(0)
    Unit cur, nxt; int ui = 0;
    if (!S.next(0, cur)) return;
    f32x4 acc[2][2][4][2];
#pragma unroll
    for (int a = 0; a < 2; ++a)
#pragma unroll
        for (int b = 0; b < 2; ++b)
#pragma unroll
            for (int m = 0; m < 4; ++m)
#pragma unroll
                for (int n = 0; n < 2; ++n) acc[a][b][m][n] = (f32x4){0.f, 0.f, 0.f, 0.f};
    bf16x8 At[4][2], B0[2][2], B1[2][2];
    const char* cA = (const char*)g.A + (size_t)cur.pm * tstep; const char* cB = (const char*)g.Bt + (size_t)cur.pn * tstep;
    S.a_ready(cur);
    if constexpr (SP2) {
        PG8_STAGE(PG8_SB(0, 0), cB, voffB); PG8_STAGE(PG8_SB(0, 1), cB + hstep, voffB); PG8_STAGE(PG8_SA(0, 0), cA, voffA); PG8_STAGE(PG8_SA(0, 1), cA + hstep, voffA);
        if (wr == 1) PG8_BAR;
        PG8_WAIT_V(2); PG8_BAR;
        PG8_STAGE(PG8_SB(1, 0), cB + kstep, voffB); PG8_STAGE(PG8_SA(1, 0), cA + kstep, voffA); PG8_STAGE(PG8_SB(1, 1), cB + hstep + kstep, voffB);
        PG8_WAIT_V(6); PG8_BAR;
    } else {
        PG8_STAGE(PG8_SB(0, 0), cB, voffB); PG8_STAGE(PG8_SA(0, 0), cA, voffA); PG8_STAGE(PG8_SB(0, 1), cB + hstep, voffB); PG8_STAGE(PG8_SA(0, 1), cA + hstep, voffA);
        if (wr == 1) PG8_BAR;
        PG8_WAIT_V(4); PG8_BAR;
        PG8_STAGE(PG8_SB(1, 0), cB + kstep, voffB); PG8_STAGE(PG8_SA(1, 0), cA + kstep, voffA); PG8_STAGE(PG8_SB(1, 1), cB + hstep + kstep, voffB);
        PG8_WAIT_V(6); PG8_BAR;
    }
    for (;;) {
        const bool has_next = S.next(ui + 1, nxt);
        const char* nA = has_next ? (const char*)g.A + (size_t)nxt.pm * tstep : cA; const char* nB = has_next ? (const char*)g.Bt + (size_t)nxt.pn * tstep : cB;
        for (int t = 0; t < nt; t += 2) {
            const bool last = (t == nt - 2);
            const char* a1 = cA + (size_t)(t + 1) * kstep;
            const char* a2 = last ? nA : cA + (size_t)(t + 2) * kstep; const char* b2 = last ? nB : cB + (size_t)(t + 2) * kstep;
            const char* a3 = a2 + kstep; const char* b3 = b2 + kstep;
            if (last && has_next) S.a_ready(nxt);
            if constexpr (SP2) {
            PG8_LDB(B0, 0, 0); PG8_LDB(B1, 0, 1); PG8_SCHED; PG8_LDA(At, 0, 0); PG8_STAGE(PG8_SA(1, 1), a1 + hstep, voffA);
            PG8_WAIT_V(8); PG8_WAIT_L(0); PG8_BAR; PG8_MMA(0, 0, At, B0); PG8_MMA(0, 1, At, B1); PG8_BAR; PG8_SCHED;
            PG8_LDA(At, 0, 1); PG8_STAGE(PG8_SB(0, 0), b2, voffB); PG8_STAGE(PG8_SB(0, 1), b2 + hstep, voffB); PG8_STAGE(PG8_SA(0, 0), a2, voffA);
            PG8_WAIT_V(8); PG8_WAIT_L(0); PG8_BAR; PG8_MMA(1, 0, At, B0); PG8_MMA(1, 1, At, B1); PG8_BAR; PG8_SCHED;
            PG8_LDB(B0, 1, 0); PG8_LDB(B1, 1, 1); PG8_SCHED; PG8_LDA(At, 1, 0); PG8_STAGE(PG8_SA(0, 1), a2 + hstep, voffA);
            PG8_WAIT_V(8); PG8_WAIT_L(0); PG8_BAR; PG8_MMA(0, 0, At, B0); PG8_MMA(0, 1, At, B1); PG8_BAR; PG8_SCHED;
            PG8_LDA(At, 1, 1); PG8_STAGE(PG8_SB(1, 0), b3, voffB); PG8_STAGE(PG8_SB(1, 1), b3 + hstep, voffB); PG8_STAGE(PG8_SA(1, 0), a3, voffA);
            PG8_WAIT_V(8); PG8_WAIT_L(0); PG8_BAR; PG8_MMA(1, 0, At, B0); PG8_MMA(1, 1, At, B1); PG8_BAR; PG8_SCHED;
            } else {
            PG8_LDB(B0, 0, 0); PG8_SCHED; PG8_LDA(At, 0, 0); PG8_STAGE(PG8_SA(1, 1), a1 + hstep, voffA);
            PG8_WAIT_L(8); PG8_BAR; PG8_WAIT_L(0); PG8_MMA(0, 0, At, B0); PG8_BAR; PG8_SCHED;
            PG8_LDB(B1, 0, 1); PG8_STAGE(PG8_SB(0, 0), b2, voffB);
            PG8_BAR; PG8_WAIT_L(0); PG8_MMA(0, 1, At, B1); PG8_BAR;
            PG8_LDA(At, 0, 1); PG8_STAGE(PG8_SA(0, 0), a2, voffA);
            PG8_BAR; PG8_WAIT_L(0); PG8_MMA(1, 0, At, B0); PG8_BAR; PG8_SCHED;
            PG8_STAGE(PG8_SB(0, 1), b2 + hstep, voffB);
            PG8_WAIT_V(6); PG8_BAR; PG8_MMA(1, 1, At, B1); PG8_BAR;
            PG8_LDB(B0, 1, 0); PG8_SCHED; PG8_LDA(At, 1, 0); PG8_STAGE(PG8_SA(0, 1), a2 + hstep, voffA);
            PG8_WAIT_L(8); PG8_BAR; PG8_WAIT_L(0); PG8_MMA(0, 0, At, B0); PG8_BAR; PG8_SCHED;
            PG8_LDB(B1, 1, 1); PG8_STAGE(PG8_SB(1, 0), b3, voffB);
            PG8_BAR; PG8_WAIT_L(0); PG8_MMA(0, 1, At, B1); PG8_BAR;
            PG8_LDA(At, 1, 1); PG8_STAGE(PG8_SA(1, 0), a3, voffA);
            PG8_BAR; PG8_WAIT_L(0); PG8_MMA(1, 0, At, B0); PG8_BAR; PG8_SCHED;
            PG8_STAGE(PG8_SB(1, 1), b3 + hstep, voffB);
            PG8_WAIT_V(6); PG8_BAR; PG8_MMA(1, 1, At, B1); PG8_BAR;
            }
        }
        if constexpr (ALIGN_EPI) { if (wr == 0) PG8_BAR; }
        if constexpr (!Epi::AFTER_DRAIN) { E(acc, cur, wr, wc, fr, fq); S.done(cur); }
        if (!has_next) break;
#pragma unroll
        for (int a = 0; a < 2; ++a)
#pragma unroll
            for (int b = 0; b < 2; ++b)
#pragma unroll
                for (int m = 0; m < 4; ++m)
#pragma unroll
                    for (int n = 0; n < 2; ++n) acc[a][b][m][n] = (f32x4){0.f, 0.f, 0.f, 0.f};
        cur = nxt; cA = nA; cB = nB; ++ui;
        if constexpr (ALIGN_EPI) { if (wr == 1) PG8_BAR; }
    }
    PG8_WAIT_V(0);
    if constexpr (!ALIGN_EPI) { if (wr == 0) PG8_BAR; }
    PG8_BAR;
    if constexpr (Epi::AFTER_DRAIN) { E.fused(acc, cur, wr, wc, fr, fq, lds, wid, lane); S.done(cur); }
#undef PG8_SA
#undef PG8_SB
#undef PG8_STAGE
#undef PG8_LDA
#undef PG8_LDB
#undef PG8_MMA
#undef PG8_WAIT_V
#undef PG8_WAIT_L
#undef PG8_BAR
#undef PG8_SCHED
}
}
namespace pg8 {
template <bool PERM>
__device__ __forceinline__ void gemm_seg(PG8_LAS unsigned char* lds, const bf16_t* A, const bf16_t* Bt, const int K, const Unit cur, f32x4 (&acc)[2][2][4][2]) {
    const int tid = threadIdx.x, wid = __builtin_amdgcn_readfirstlane(tid >> 6), lane = tid & 63, wr = wid >> 2, wc = wid & 3, fr = lane & 15, fq = lane >> 4;
    const int nt = K / BK;
    unsigned voffA[2], voffB[2];
#pragma unroll
    for (int i = 0; i < 2; ++i) { int R, C; stage_rc(tid * 16 + i * 8192, R, C); const int Rb = PERM ? ((R & ~31) + perm32(R & 31)) : R;
        voffA[i] = (unsigned)(R * K + C) * 2u; voffB[i] = (unsigned)(Rb * K + C) * 2u; }
    const size_t kstep = (size_t)(BK * 2);
    const size_t hstep = (size_t)HALF * K * 2;
    const size_t tstep = 2 * hstep;
    const unsigned ldsw = (unsigned)wid * 1024u;
    const int aoff = lds_byte(wr * 64 + fr, fq * 8), boff = lds_byte(wc * 32 + fr, fq * 8);
#define PG8_SA(b, h) (((b) * 2 + (h)) * HTB)
#define PG8_SB(b, h) ((4 + (b) * 2 + (h)) * HTB)
#define PG8_STAGE(bufoff, gbase, voff) do { _Pragma("unroll") for (int _i = 0; _i < 2; ++_i) \
        __builtin_amdgcn_global_load_lds((const unsigned*)((const char*)(gbase) + (voff)[_i]), (PG8_LAS unsigned*)(lds + (bufoff) + ldsw + _i * 8192), 16, 0, 0); } while (0)
#define PG8_LDA(dst, b, h) do { _Pragma("unroll") for (int m = 0; m < 4; ++m) _Pragma("unroll") for (int k = 0; k < 2; ++k) dst[m][k] = *(const PG8_LAS bf16x8*)(lds + PG8_SA(b, h) + aoff + m * 2048 + k * 1024); } while (0)
#define PG8_LDB(dst, b, h) do { _Pragma("unroll") for (int n = 0; n < 2; ++n) _Pragma("unroll") for (int k = 0; k < 2; ++k) dst[n][k] = *(const PG8_LAS bf16x8*)(lds + PG8_SB(b, h) + boff + n * 2048 + k * 1024); } while (0)
#define PG8_MMA(ai, bj, At, Bt_) do { __builtin_amdgcn_s_setprio(1); _Pragma("unroll") for (int m = 0; m < 4; ++m) _Pragma("unroll") for (int n = 0; n < 2; ++n) _Pragma("unroll") for (int k = 0; k < 2; ++k) \
        acc[ai][bj][m][n] = __builtin_amdgcn_mfma_f32_16x16x32_bf16(Bt_[n][k], At[m][k], acc[ai][bj][m][n], 0, 0, 0); __builtin_amdgcn_s_setprio(0); } while (0)
#define PG8_WAIT_V(n) asm volatile("s_waitcnt vmcnt(" #n ")" ::: "memory")
#define PG8_WAIT_L(n) asm volatile("s_waitcnt lgkmcnt(" #n ")" ::: "memory")
#define PG8_BAR __builtin_amdgcn_s_barrier()
#define PG8_SCHED __builtin_amdgcn_sched_barrier(0)
    bf16x8 At[4][2], B0[2][2], B1[2][2];
    const char* cA = (const char*)A + (size_t)cur.pm * tstep; const char* cB = (const char*)Bt + (size_t)cur.pn * tstep;
    PG8_STAGE(PG8_SB(0, 0), cB, voffB); PG8_STAGE(PG8_SB(0, 1), cB + hstep, voffB); PG8_STAGE(PG8_SA(0, 0), cA, voffA); PG8_STAGE(PG8_SA(0, 1), cA + hstep, voffA);
    if (wr == 1) PG8_BAR;
    PG8_WAIT_V(2); PG8_BAR;
    PG8_STAGE(PG8_SB(1, 0), cB + kstep, voffB); PG8_STAGE(PG8_SA(1, 0), cA + kstep, voffA); PG8_STAGE(PG8_SB(1, 1), cB + hstep + kstep, voffB);
    PG8_WAIT_V(6); PG8_BAR;
    for (int t = 0; t < nt; t += 2) {
        const bool last = (t == nt - 2);
        const char* a1 = cA + (size_t)(t + 1) * kstep;
        const char* a2 = last ? cA : cA + (size_t)(t + 2) * kstep; const char* b2 = last ? cB : cB + (size_t)(t + 2) * kstep;
        const char* a3 = a2 + kstep; const char* b3 = b2 + kstep;
        PG8_LDB(B0, 0, 0); PG8_LDB(B1, 0, 1); PG8_SCHED; PG8_LDA(At, 0, 0); PG8_STAGE(PG8_SA(1, 1), a1 + hstep, voffA);
        PG8_WAIT_V(8); PG8_WAIT_L(0); PG8_BAR; PG8_MMA(0, 0, At, B0); PG8_MMA(0, 1, At, B1); PG8_BAR; PG8_SCHED;
        PG8_LDA(At, 0, 1); PG8_STAGE(PG8_SB(0, 0), b2, voffB); PG8_STAGE(PG8_SB(0, 1), b2 + hstep, voffB); PG8_STAGE(PG8_SA(0, 0), a2, voffA);
        PG8_WAIT_V(8); PG8_WAIT_L(0); PG8_BAR; PG8_MMA(1, 0, At, B0); PG8_MMA(1, 1, At, B1); PG8_BAR; PG8_SCHED;
        PG8_LDB(B0, 1, 0); PG8_LDB(B1, 1, 1); PG8_SCHED; PG8_LDA(At, 1, 0); PG8_STAGE(PG8_SA(0, 1), a2 + hstep, voffA);
        PG8_WAIT_V(8); PG8_WAIT_L(0); PG8_BAR; PG8_MMA(0, 0, At, B0); PG8_MMA(0, 1, At, B1); PG8_BAR; PG8_SCHED;
        PG8_LDA(At, 1, 1); PG8_STAGE(PG8_SB(1, 0), b3, voffB); PG8_STAGE(PG8_SB(1, 1), b3 + hstep, voffB); PG8_STAGE(PG8_SA(1, 0), a3, voffA);
        PG8_WAIT_V(8); PG8_WAIT_L(0); PG8_BAR; PG8_MMA(1, 0, At, B0); PG8_MMA(1, 1, At, B1); PG8_BAR; PG8_SCHED;
    }
    PG8_WAIT_V(0);
    if (wr == 0) PG8_BAR;
    PG8_BAR;
#undef PG8_SA
#undef PG8_SB
#undef PG8_STAGE
#undef PG8_LDA
#undef PG8_LDB
#undef PG8_MMA
#undef PG8_WAIT_V
#undef PG8_WAIT_L
#undef PG8_BAR
#undef PG8_SCHED
}
}
constexpr int NB = 8, SEQ = 2048, DM = 1024, T = NB * SEQ, NH = 4, DH = 128, DML = 512, DS5 = 512, NG = 32, NP = 64, SG = 16, DFF = 2816, DIN = 2568;
constexpr int NPROJ = 2560;
constexpr float EPS = 1e-6f;
constexpr int NWAVES = 8;
constexpr int LDS_BYTES = 163840;

constexpr size_t MiB = 1u << 20;
constexpr size_t WS_CTL = 0, CTL_ZERO_BYTES = 1 * MiB;
constexpr size_t WS_W1T = 2 * MiB;
constexpr size_t WS_WGLU = 7 * MiB;
constexpr size_t WS_WOHS = 8 * MiB;
constexpr size_t WS_WOHM = 9 * MiB;
constexpr size_t WS_WGU = 10 * MiB;
constexpr size_t WS_WD = 21 * MiB;
constexpr size_t WS_TAB = 27 * MiB;
constexpr size_t WS_GT = 28 * MiB;
constexpr size_t WS_RS = 29 * MiB;
constexpr size_t WS_MST = 30 * MiB;
constexpr size_t WS_XN = 32 * MiB;
constexpr size_t WS_P = 64 * MiB;
constexpr size_t WS_G = 144 * MiB;
constexpr size_t WS_ACT = 64 * MiB;
constexpr size_t WS_HS = 160 * MiB;
constexpr size_t WS_HM = 176 * MiB;
constexpr size_t WS_CLOC = 192 * MiB;
constexpr size_t WS_END = 200 * MiB;
constexpr int TB_ABR = 0, TB_ABI = 2048, TB_A256R = 4096, TB_A256I = 6144, TB_BBR = 8192, TB_BBI = 8192 + 32768;
constexpr int RS1 = 0, RS2 = T * 2, RS3 = T * 2 + T * 4;

#define LAS __attribute__((address_space(3)))
typedef unsigned short bf16;
typedef unsigned v4u __attribute__((ext_vector_type(4)));
typedef unsigned v2u __attribute__((ext_vector_type(2)));
typedef float f32x4 __attribute__((ext_vector_type(4)));
#define LDS_WAIT() asm volatile("s_waitcnt lgkmcnt(0)" ::: "memory")
#define VM_WAIT() asm volatile("s_waitcnt vmcnt(0)" ::: "memory")
__device__ __forceinline__ unsigned f2bf(float f) { unsigned u = __builtin_bit_cast(unsigned, f); return (u + 0x7fffu + ((u >> 16) & 1u)) >> 16; }
__device__ __forceinline__ unsigned pk2(float lo, float hi) { return f2bf(lo) | (f2bf(hi) << 16); }
__device__ __forceinline__ float bf2f(unsigned short b) { return __builtin_bit_cast(float, (unsigned)b << 16); }
__device__ __forceinline__ float bflo(unsigned w) { return __builtin_bit_cast(float, w << 16); }
__device__ __forceinline__ float bfhi(unsigned w) { return __builtin_bit_cast(float, w & 0xffff0000u); }
__device__ __forceinline__ float wave_sum(float v) {
#pragma unroll
    for (int o = 1; o < 64; o <<= 1) v += __shfl_xor(v, o);
    return v;
}
__device__ __forceinline__ float sigmoidf_(float z) { return 1.0f / (1.0f + __expf(-z)); }
__device__ __forceinline__ float gelu_tanh(float y) { const float u = 0.7978845608028654f * (y + 0.044715f * y * y * y); const float e = __expf(2.0f * u); const float th = 1.0f - 2.0f / (e + 1.0f); return 0.5f * y * (1.0f + th); }

struct Args { const float* in[23]; float* out; unsigned char* ws; int ph_lo, ph_hi; };

namespace pg8 {
struct EpiGlu {
    static constexpr bool PERM = true, AFTER_DRAIN = true;
    const bf16_t* G; bf16_t* HS; const float* bias; const float* gamma; float* rs;
    __device__ __forceinline__ void fused(f32x4 (&acc)[2][2][4][2], const Unit& u, int wr, int wc, int fr, int fq, PG8_LAS unsigned char* lds, int wid, int lane) const {
        PG8_LAS float* part = (PG8_LAS float*)lds;
        const int colb = u.pn * BM + wc * 32 + 8 * fq;
#pragma unroll
        for (int ai = 0; ai < 2; ++ai)
#pragma unroll
            for (int m = 0; m < 4; ++m) {
                const int rl = ai * HALF + wr * 64 + m * 16 + fr; const size_t row = (size_t)u.pm * BM + rl; float ss = 0.f;
#pragma unroll
                for (int bj = 0; bj < 2; ++bj) {
                    const int col = colb + bj * HALF;
                    const u32x4 gv = *(const u32x4*)(G + row * 512 + col);
                    const f32x4 b0 = *(const f32x4*)(bias + col), b1 = *(const f32x4*)(bias + col + 4), g0 = *(const f32x4*)(gamma + col), g1 = *(const f32x4*)(gamma + col + 4);
                    const f32x4 z0 = acc[ai][bj][m][0] + b0, z1 = acc[ai][bj][m][1] + b1;
                    float gg[8]; gg[0] = bflo(gv.x); gg[1] = bfhi(gv.x); gg[2] = bflo(gv.y); gg[3] = bfhi(gv.y); gg[4] = bflo(gv.z); gg[5] = bfhi(gv.z); gg[6] = bflo(gv.w); gg[7] = bfhi(gv.w);
                    float o[8];
#pragma unroll
                    for (int e = 0; e < 4; ++e) { const float a = gg[e] * sigmoidf_(z0[e]); ss += a * a; o[e] = a * g0[e]; const float c = gg[4 + e] * sigmoidf_(z1[e]); ss += c * c; o[4 + e] = c * g1[e]; }
                    u32x4 w; w.x = cvt_pk_bf16(o[0], o[1]); w.y = cvt_pk_bf16(o[2], o[3]); w.z = cvt_pk_bf16(o[4], o[5]); w.w = cvt_pk_bf16(o[6], o[7]);
                    *(u32x4*)(HS + row * 512 + col) = w;
                }
                ss += __shfl_xor(ss, 16); ss += __shfl_xor(ss, 32);
                if (fq == 0) part[rl * 4 + wc] = ss;
            }
        __syncthreads();
        const int tid = threadIdx.x;
        if (tid < 256) rs[((size_t)u.pm * BM + tid) * 2 + u.pn] = (part[tid * 4] + part[tid * 4 + 1]) + (part[tid * 4 + 2] + part[tid * 4 + 3]);
    }
};
struct EpiRes {
    static constexpr bool PERM = false, AFTER_DRAIN = true;
    const float* base; float* out; bf16_t* ob; float* rs;
    __device__ __forceinline__ void fused(f32x4 (&acc)[2][2][4][2], const Unit& u, int wr, int wc, int fr, int fq, PG8_LAS unsigned char* lds, int wid, int lane) const {
        PG8_LAS float* part = (PG8_LAS float*)lds;
        const int col0 = u.pn * BM + wc * 32 + 4 * fq;
#pragma unroll
        for (int ai = 0; ai < 2; ++ai)
#pragma unroll
            for (int m = 0; m < 4; ++m) {
                const int rl = ai * HALF + wr * 64 + m * 16 + fr; const size_t off = ((size_t)u.pm * BM + rl) * 1024 + col0; float ss = 0.f;
#pragma unroll
                for (int bj = 0; bj < 2; ++bj)
#pragma unroll
                    for (int n = 0; n < 2; ++n) {
                        const f32x4 bs = *(const f32x4*)(base + off + bj * HALF + n * 16); const f32x4 h = bs + acc[ai][bj][m][n];
                        *(f32x4*)(out + off + bj * HALF + n * 16) = h; ss += (h[0] * h[0] + h[1] * h[1]) + (h[2] * h[2] + h[3] * h[3]);
                        if (ob) { typedef unsigned u32x2v __attribute__((ext_vector_type(2))); u32x2v w; w.x = cvt_pk_bf16(h[0], h[1]); w.y = cvt_pk_bf16(h[2], h[3]); *(u32x2v*)(ob + off + bj * HALF + n * 16) = w; }
                    }
                ss += __shfl_xor(ss, 16); ss += __shfl_xor(ss, 32);
                if (fq == 0) part[rl * 4 + wc] = ss;
            }
        __syncthreads();
        const int tid = threadIdx.x;
        if (tid < 256) rs[((size_t)u.pm * BM + tid) * 4 + u.pn] = (part[tid * 4] + part[tid * 4 + 1]) + (part[tid * 4 + 2] + part[tid * 4 + 3]);
    }
};
struct EpiGU {
    static constexpr bool PERM = true, AFTER_DRAIN = false;
    bf16_t* ACT; const float* rs;
    __device__ __forceinline__ void operator()(const f32x4 (&acc)[2][2][4][2], const Unit& u, int wr, int wc, int fr, int fq) const {
        const int col = u.pn * HALF + wc * 32 + 8 * fq;
#pragma unroll
        for (int ai = 0; ai < 2; ++ai)
#pragma unroll
            for (int m = 0; m < 4; ++m) {
                const size_t row = (size_t)u.pm * BM + ai * HALF + wr * 64 + m * 16 + fr;
                const f32x4 p = *(const f32x4*)(rs + row * 4); const float r = 1.0f / sqrtf(((p[0] + p[1]) + (p[2] + p[3])) * (1.0f / 1024.0f) + 1e-6f);
                float o[8];
#pragma unroll
                for (int n = 0; n < 2; ++n)
#pragma unroll
                    for (int e = 0; e < 4; ++e) { const float g = acc[ai][0][m][n][e] * r, up = acc[ai][1][m][n][e] * r; o[4 * n + e] = g * sigmoidf_(g) * up; }
                u32x4 w; w.x = cvt_pk_bf16(o[0], o[1]); w.y = cvt_pk_bf16(o[2], o[3]); w.z = cvt_pk_bf16(o[4], o[5]); w.w = cvt_pk_bf16(o[6], o[7]);
                *(u32x4*)(ACT + row * 2816 + col) = w;
            }
    }
};
}

__device__ __forceinline__ void p0_transpose_item(const float* W, int ldw, int k0, int csrc, bf16* WT, int ldt, int drow, const float* kscale, LAS float* scr, int lane) {
#pragma unroll 8
    for (int i = 0; i < 32; ++i) { const int kk = 2 * i + (lane >> 5); const float s = kscale ? kscale[k0 + kk] : 1.0f; scr[kk * 33 + (lane & 31)] = W[(size_t)(k0 + kk) * ldw + csrc + (lane & 31)] * s; }
    LDS_WAIT(); asm volatile("" ::: "memory");
    const int c = lane & 7;
#pragma unroll
    for (int j = 0; j < 4; ++j) { const int n = (lane >> 3) + 8 * j; const LAS float* s = scr + (8 * c) * 33 + n;
        v4u o; o.x = pk2(s[0 * 33], s[1 * 33]); o.y = pk2(s[2 * 33], s[3 * 33]); o.z = pk2(s[4 * 33], s[5 * 33]); o.w = pk2(s[6 * 33], s[7 * 33]);
        *(v4u*)(WT + (size_t)(drow + n) * ldt + k0 + 8 * c) = o; }
    LDS_WAIT(); asm volatile("" ::: "memory");
}
__device__ __forceinline__ void p0_prologue(const Args& a, LAS unsigned char* lds, int gw, int NGW, int wave, int lane, int tid) {
    unsigned char* ws = a.ws;
    const float* x = a.in[0]; const float* g1 = a.in[1]; const float* w_in = a.in[2]; const float* if_bias = a.in[3];
    LAS float* wg = (LAS float*)(lds + 73728);
    for (int i = tid; i < 8192; i += 512) wg[i] = w_in[(size_t)(i >> 3) * DIN + 2048 + (i & 7)];
    __syncthreads();
    LAS float* scr = (LAS float*)(lds + wave * 8448);
    constexpr int I0 = 16 * 64, I1 = 16 * 16, I2 = 8 * 16, I3 = 8 * 32, I4 = 8 * 32, I5 = 16 * 88, I6 = 16 * 88, I7 = 44 * 32;
    constexpr int NITEMS = I0 + I1 + I2 + I3 + I4 + I5 + I6 + I7;
    for (int it = gw; it < NITEMS; it += NGW) {
        int r = it;
        if (r < I0) { const int kb = r / 64, nb = r % 64; p0_transpose_item(w_in, DIN, 64 * kb, 32 * nb, (bf16*)(ws + WS_W1T), 1024, 32 * nb, nullptr, scr, lane); continue; } r -= I0;
        if (r < I1) { const int kb = r / 16, nb = r % 16; p0_transpose_item(w_in, DIN, 64 * kb, 2056 + 32 * nb, (bf16*)(ws + WS_W1T), 1024, 2048 + 32 * nb, nullptr, scr, lane); continue; } r -= I1;
        if (r < I2) { const int kb = r / 16, nb = r % 16; p0_transpose_item(a.in[14], 512, 64 * kb, 32 * nb, (bf16*)(ws + WS_WGLU), 512, 32 * nb, nullptr, scr, lane); continue; } r -= I2;
        if (r < I3) { const int kb = r / 32, nb = r % 32; p0_transpose_item(a.in[17] + (size_t)512 * 1024, 1024, 64 * kb, 32 * nb, (bf16*)(ws + WS_WOHS), 512, 32 * nb, nullptr, scr, lane); continue; } r -= I3;
        if (r < I4) { const int kb = r / 32, nb = r % 32; p0_transpose_item(a.in[17], 1024, 64 * kb, 32 * nb, (bf16*)(ws + WS_WOHM), 512, 32 * nb, nullptr, scr, lane); continue; } r -= I4;
        if (r < I5) { const int kb = r / 88, nb = r % 88, n0 = 32 * nb; p0_transpose_item(a.in[19], DFF, 64 * kb, n0, (bf16*)(ws + WS_WGU), 1024, 256 * (n0 / 128) + (n0 % 128), a.in[18], scr, lane); continue; } r -= I5;
        if (r < I6) { const int kb = r / 88, nb = r % 88, n0 = 32 * nb; p0_transpose_item(a.in[20], DFF, 64 * kb, n0, (bf16*)(ws + WS_WGU), 1024, 256 * (n0 / 128) + 128 + (n0 % 128), a.in[18], scr, lane); continue; } r -= I6;
        { const int kb = r / 32, nb = r % 32; p0_transpose_item(a.in[21], 1024, 64 * kb, 32 * nb, (bf16*)(ws + WS_WD), DFF, 32 * nb, nullptr, scr, lane); }
    }
    bf16* XN = (bf16*)(ws + WS_XN); float* GT = (float*)(ws + WS_GT);
    for (int m = gw; m < T; m += NGW) {
        const f32x4* xr = (const f32x4*)(x + (size_t)m * DM) + lane;
        f32x4 v[4]; float s = 0.f;
#pragma unroll
        for (int j = 0; j < 4; ++j) { v[j] = xr[64 * j]; s += (v[j].x * v[j].x + v[j].y * v[j].y) + (v[j].z * v[j].z + v[j].w * v[j].w); }
        const float rstd = 1.0f / sqrtf(wave_sum(s) * (1.0f / DM) + EPS);
        float ga[8];
#pragma unroll
        for (int i = 0; i < 8; ++i) ga[i] = 0.f;
        unsigned long long* o8 = (unsigned long long*)(XN + (size_t)m * DM) + lane;
#pragma unroll
        for (int j = 0; j < 4; ++j) {
            const f32x4 gv = ((const f32x4*)g1)[lane + 64 * j]; const f32x4 y = v[j] * rstd * gv;
            o8[64 * j] = (unsigned long long)pk2(y.x, y.y) | ((unsigned long long)pk2(y.z, y.w) << 32);
#pragma unroll
            for (int e = 0; e < 4; ++e) { const LAS f32x4* w4 = (const LAS f32x4*)(wg + (size_t)(4 * lane + 256 * j + e) * 8); const f32x4 wa = w4[0], wb = w4[1];
                ga[0] += y[e] * wa[0]; ga[1] += y[e] * wa[1]; ga[2] += y[e] * wa[2]; ga[3] += y[e] * wa[3]; ga[4] += y[e] * wb[0]; ga[5] += y[e] * wb[1]; ga[6] += y[e] * wb[2]; ga[7] += y[e] * wb[3]; }
        }
        float mine = 0.f;
#pragma unroll
        for (int i = 0; i < 8; ++i) { const float tsum = wave_sum(ga[i]); if (lane == i) mine = tsum; }
        if (lane < 8) { float z = mine + if_bias[lane]; if (lane >= 4) z = fminf(z, 0.f) - log1pf(__expf(-fabsf(z))); GT[(size_t)m * 8 + lane] = z; }
    }
    const int gt = gw * 64 + lane;
    if (gt < NG * NP) {
        const int g = gt >> 6;
        const double dt = exp((double)a.in[8][g]); const double ar = (double)a.in[6][gt], ai = (double)a.in[7][gt];
        float* tab = (float*)(ws + WS_TAB);
        double mag = exp(dt * ar), ang = dt * ai;
        auto sincos_d = [](double th, double& sn, double& cs) { const double twopi = 6.283185307179586476925; th -= twopi * rint(th / twopi); const double t2 = th * th; double ss = 1.0, cc = 1.0;
            for (int k = 20; k >= 1; --k) { ss = 1.0 - ss * t2 / (double)((2 * k) * (2 * k + 1)); cc = 1.0 - cc * t2 / (double)((2 * k - 1) * (2 * k)); } sn = th * ss; cs = cc; };
        double sn, cs; sincos_d(ang, sn, cs);
        const double abr = mag * cs, abi = mag * sn, den = ar * ar + ai * ai, nr = abr - 1.0;
        const double zr = (nr * ar + abi * ai) / den, zi = (abi * ar - nr * ai) / den;
        tab[TB_ABR + gt] = (float)abr; tab[TB_ABI + gt] = (float)abi;
        double sn2, cs2; sincos_d(256.0 * ang, sn2, cs2); const double mag2 = exp(256.0 * dt * ar);
        tab[TB_A256R + gt] = (float)(mag2 * cs2); tab[TB_A256I + gt] = (float)(mag2 * sn2);
        for (int h = 0; h < SG; ++h) { const double br = (double)a.in[9][(size_t)gt * SG + h], bi = (double)a.in[10][(size_t)gt * SG + h];
            tab[TB_BBR + gt * SG + h] = (float)(zr * br - zi * bi); tab[TB_BBI + gt * SG + h] = (float)(zr * bi + zi * br); }
    }
}

__device__ __forceinline__ void mlstm_slow(const Args& a, LAS unsigned char* lds, int bh, int tid, int lane, int wave) {
    unsigned char* ws = a.ws; const bf16* P = (const bf16*)(ws + WS_P); const float* GT = (const float*)(ws + WS_GT); bf16* HM = (bf16*)(ws + WS_HM);
    const float* conv = a.in[4]; const float* gamv = a.in[5];
    const int b = bh >> 2, h = bh & 3;
    LAS float* qs = (LAS float*)lds; LAS float* ks = qs + 128; LAS float* vs = ks + 128; LAS float* red = vs + 128;
    const int dv = tid >> 2, part = tid & 3;
    float C[32];
#pragma unroll
    for (int j = 0; j < 32; ++j) C[j] = 0.f;
    float nown = 0.f, mst = 0.f; const float gam = gamv[h * 128 + dv];
    for (int t = 0; t < SEQ; ++t) {
        const size_t row = (size_t)b * SEQ + t;
        if (tid < 256) { const int d = tid & 127, isk = tid >> 7, ch = isk * 512 + h * 128 + d; float acc = 0.f;
#pragma unroll
            for (int kk = 0; kk < 4; ++kk) { const int tt = t - 3 + kk; if (tt >= 0) acc += conv[kk * 1024 + ch] * bf2f(P[((size_t)b * SEQ + tt) * NPROJ + ch]); }
            acc = acc * sigmoidf_(acc); if (isk) { acc *= 0.08838834764831845f; ks[d] = acc; } else qs[d] = acc;
        } else if (tid < 384) { const int d = tid - 256; vs[d] = bf2f(P[row * NPROJ + 1024 + h * 128 + d]); }
        __syncthreads();
        const float li = GT[row * 8 + h], lf = GT[row * 8 + 4 + h];
        const float mn = fmaxf(lf + mst, li), fa = __expf(lf + mst - mn), fc = __expf(li - mn); mst = mn;
        const float vv = vs[dv] * fc; float num = 0.f;
#pragma unroll
        for (int j = 0; j < 32; ++j) { C[j] = fa * C[j] + ks[32 * part + j] * vv; num += C[j] * qs[32 * part + j]; }
        num += __shfl_xor(num, 1); num += __shfl_xor(num, 2);
        float pd = 0.f; if (tid < 128) { nown = fa * nown + fc * ks[tid]; pd = nown * qs[tid]; }
        pd = wave_sum(pd); if (lane == 0) red[wave] = pd;
        __syncthreads();
        const float den = red[0] + red[1];
        const float ht = num / fmaxf(fabsf(den), __expf(-mst));
        const float og = sigmoidf_(bf2f(P[row * NPROJ + 1536 + h * 128 + dv])); const float hmv = og * ht;
        float s1 = wave_sum(part == 0 ? hmv : 0.f); if (lane == 0) red[8 + wave] = s1;
        __syncthreads();
        float mu = 0.f;
#pragma unroll
        for (int w = 0; w < 8; ++w) mu += red[8 + w];
        mu *= (1.0f / 128.0f);
        const float dd = hmv - mu; float s2 = wave_sum(part == 0 ? dd * dd : 0.f); if (lane == 0) red[16 + wave] = s2;
        __syncthreads();
        float var = 0.f;
#pragma unroll
        for (int w = 0; w < 8; ++w) var += red[16 + w];
        var *= (1.0f / 128.0f);
        if (part == 0) HM[row * 512 + h * 128 + dv] = (bf16)f2bf(dd * (1.0f / sqrtf(var + EPS)) * gam);
    }
}
__device__ __forceinline__ void s5_slow(const Args& a, int bg, int lane) {
    unsigned char* ws = a.ws; const bf16* P = (const bf16*)(ws + WS_P); bf16* G = (bf16*)(ws + WS_G); const float* tab = (const float*)(ws + WS_TAB);
    const int b = bg >> 5, g = bg & 31, gp = g * 64 + lane;
    const float abr = tab[TB_ABR + gp], abi = tab[TB_ABI + gp];
    float bbr[16], bbi[16], cr[16], ci[16];
#pragma unroll
    for (int h = 0; h < 16; ++h) { bbr[h] = tab[TB_BBR + gp * 16 + h]; bbi[h] = tab[TB_BBI + gp * 16 + h]; cr[h] = a.in[11][(size_t)g * 1024 + h * 64 + lane]; ci[h] = a.in[12][(size_t)g * 1024 + h * 64 + lane]; }
    const float dsk = a.in[13][g * 16 + (lane & 15)];
    float xr = 0.f, xi = 0.f;
    for (int t = 0; t < SEQ; ++t) {
        const size_t row = (size_t)b * SEQ + t;
        const v4u u0 = *(const v4u*)(P + row * NPROJ + 2048 + g * 16), u1 = *(const v4u*)(P + row * NPROJ + 2048 + g * 16 + 8);
        float u[16]; u[0] = bflo(u0.x); u[1] = bfhi(u0.x); u[2] = bflo(u0.y); u[3] = bfhi(u0.y); u[4] = bflo(u0.z); u[5] = bfhi(u0.z); u[6] = bflo(u0.w); u[7] = bfhi(u0.w);
        u[8] = bflo(u1.x); u[9] = bfhi(u1.x); u[10] = bflo(u1.y); u[11] = bfhi(u1.y); u[12] = bflo(u1.z); u[13] = bfhi(u1.z); u[14] = bflo(u1.w); u[15] = bfhi(u1.w);
        float bur = 0.f, bui = 0.f;
#pragma unroll
        for (int h = 0; h < 16; ++h) { bur += bbr[h] * u[h]; bui += bbi[h] * u[h]; }
        const float nxr = abr * xr - abi * xi + bur, nxi = abr * xi + abi * xr + bui; xr = nxr; xi = nxi;
        float ymine = 0.f, ul = 0.f;
#pragma unroll
        for (int h = 0; h < 16; ++h) { const float yh = wave_sum(cr[h] * xr - ci[h] * xi); if (lane == h) { ymine = yh; ul = u[h]; } }
        if (lane < 16) G[row * 512 + g * 16 + lane] = (bf16)f2bf(gelu_tanh(ymine + dsk * ul));
    }
}

__global__ void __launch_bounds__(NWAVES * 64, 2) fwd(Args args) {
    extern __shared__ __attribute__((aligned(16))) unsigned char lds_raw[];
    LAS unsigned char* lds = (LAS unsigned char*)lds_raw;
    const int tid = threadIdx.x, lane = tid & 63, wave = __builtin_amdgcn_readfirstlane(tid >> 6);
    const int G_ = gridDim.x, bx = blockIdx.x;
    const int vcu = (G_ % 8 == 0) ? (bx % 8) * (G_ / 8) + bx / 8 : bx;
    const int gw = vcu * NWAVES + wave, NGW = G_ * NWAVES;
    unsigned char* ws = args.ws;
    const int lo = args.ph_lo, hi = args.ph_hi;
#define IN(k) (lo <= (k) && (k) < hi)
#define SEAM(k) do { if (IN(k) && IN((k) + 1)) { cooperative_groups::this_grid().sync(); } } while (0)
    typedef pg8::bf16_t pbf;

    if (IN(0)) { p0_prologue(args, lds, gw, NGW, wave, lane, tid); __syncthreads(); }
    SEAM(0);
    if (IN(1)) {
        pg8::Gemm g{(const pbf*)(ws + WS_XN), (const pbf*)(ws + WS_W1T), T, NPROJ, DM}; pg8::StaticOrder S; S.init(T, NPROJ, G_, bx);
        pg8::EpiBf16<0> E{(pbf*)(ws + WS_P), NPROJ, nullptr, 0, 0, 1.f};
        pg8::gemm_phase<pg8::EpiBf16<0>, pg8::StaticOrder, true, true>(lds, g, S, E);
    }
    SEAM(1);
    if (IN(2)) {
        if (bx < 32) mlstm_slow(args, lds, bx, tid, lane, wave);
        else if (bx < 64) s5_slow(args, (bx - 32) * 8 + wave, lane);
    }
    SEAM(2);
    if (IN(3)) {
        pg8::Gemm g{(const pbf*)(ws + WS_G), (const pbf*)(ws + WS_WGLU), T, 512, 512}; pg8::StaticOrder S; S.init(T, 512, G_, bx);
        pg8::EpiGlu E{(const pbf*)(ws + WS_G), (pbf*)(ws + WS_HS), args.in[15], args.in[16], (float*)(ws + WS_RS) + RS1};
        pg8::gemm_phase<pg8::EpiGlu, pg8::StaticOrder, false, true>(lds, g, S, E);
    }
    SEAM(3);
    if (IN(4)) {
        pg8::StaticOrder S; S.init(T, DM, G_, bx); pg8::Unit u;
        if (S.next(0, u)) {
            pg8::f32x4 acc[2][2][4][2];
#pragma unroll
            for (int i = 0; i < 2; ++i)
#pragma unroll
                for (int j = 0; j < 2; ++j)
#pragma unroll
                    for (int m = 0; m < 4; ++m)
#pragma unroll
                        for (int n = 0; n < 2; ++n) acc[i][j][m][n] = (pg8::f32x4){0.f, 0.f, 0.f, 0.f};
            pg8::gemm_seg<false>(lds, (const pbf*)(ws + WS_HS), (const pbf*)(ws + WS_WOHS), 512, u, acc);
            { const int wr = wave >> 2, fr = lane & 15; const float* rs1 = (const float*)(ws + WS_RS) + RS1;
#pragma unroll
              for (int ai = 0; ai < 2; ++ai)
#pragma unroll
                for (int m = 0; m < 4; ++m) { const size_t row = (size_t)u.pm * 256 + ai * 128 + wr * 64 + m * 16 + fr; const float r2 = 1.0f / sqrtf((rs1[row * 2] + rs1[row * 2 + 1]) * (1.0f / 512.0f) + EPS);
#pragma unroll
                    for (int bj = 0; bj < 2; ++bj)
#pragma unroll
                        for (int n = 0; n < 2; ++n) acc[ai][bj][m][n] *= r2; } }
            pg8::gemm_seg<false>(lds, (const pbf*)(ws + WS_HM), (const pbf*)(ws + WS_WOHM), 512, u, acc);
            pg8::EpiRes E{args.in[0], args.out, (pbf*)(ws + WS_XN), (float*)(ws + WS_RS) + RS2};
            E.fused(acc, u, wave >> 2, wave & 3, lane & 15, lane >> 4, lds, wave, lane);
        }
    }
    SEAM(4);
    if (IN(5)) {
        pg8::Gemm g{(const pbf*)(ws + WS_XN), (const pbf*)(ws + WS_WGU), T, 2 * DFF, DM}; pg8::StaticOrder S; S.init(T, 2 * DFF, G_, bx);
        pg8::EpiGU E{(pbf*)(ws + WS_ACT), (const float*)(ws + WS_RS) + RS2};
        pg8::gemm_phase<pg8::EpiGU, pg8::StaticOrder, true, true>(lds, g, S, E);
    }
    SEAM(5);
    if (IN(6)) {
        pg8::Gemm g{(const pbf*)(ws + WS_ACT), (const pbf*)(ws + WS_WD), T, DM, DFF}; pg8::StaticOrder S; S.init(T, DM, G_, bx);
        pg8::EpiRes E{args.out, args.out, nullptr, (float*)(ws + WS_RS) + RS3};
        pg8::gemm_phase<pg8::EpiRes, pg8::StaticOrder, false, true>(lds, g, S, E);
    }
    SEAM(6);
    if (IN(7)) {
        const float* rs3 = (const float*)(ws + WS_RS) + RS3; const float* gf = args.in[22];
        for (int m = gw; m < T; m += NGW) {
            const f32x4 p = *(const f32x4*)(rs3 + (size_t)m * 4); const float r = 1.0f / sqrtf(((p[0] + p[1]) + (p[2] + p[3])) * (1.0f / DM) + EPS);
            f32x4* o = (f32x4*)(args.out + (size_t)m * DM) + lane;
#pragma unroll
            for (int j = 0; j < 4; ++j) { const f32x4 gv = ((const f32x4*)gf)[lane + 64 * j]; o[64 * j] = o[64 * j] * r * gv; }
        }
    }
#undef IN
#undef SEAM
}

#ifndef N_LAUNCHES
#define N_LAUNCHES 8
#endif
extern "C" void kernel_launch(void* const* d_in, const int* in_sizes, int n_in, void* d_out, int out_size, void* d_ws, size_t ws_size, hipStream_t stream) {
    static int grid = 0;
    if (grid == 0) {
        if (n_in != 23 || out_size != T * DM || ws_size < WS_END) { fprintf(stderr, "kernel_launch: unexpected problem shape (n_in %d out %d ws %zu)\n", n_in, out_size, ws_size); grid = -1; return; }
        int dev = 0, cus = 0, per_cu = 0;
        if (hipGetDevice(&dev) != hipSuccess || hipDeviceGetAttribute(&cus, hipDeviceAttributeMultiprocessorCount, dev) != hipSuccess) { grid = -1; return; }
        if (hipFuncSetAttribute((const void*)fwd, hipFuncAttributeMaxDynamicSharedMemorySize, LDS_BYTES) != hipSuccess) { fprintf(stderr, "kernel_launch: hipFuncSetAttribute failed\n"); grid = -1; return; }
        if (hipOccupancyMaxActiveBlocksPerMultiprocessor(&per_cu, (const void*)fwd, NWAVES * 64, LDS_BYTES) != hipSuccess || per_cu < 1) { fprintf(stderr, "kernel_launch: occupancy query says %d blocks per CU\n", per_cu); (void)hipGetLastError(); grid = -1; return; }
        grid = cus * 1;
        if (grid != 256) fprintf(stderr, "kernel_launch: %d CUs (built for 256)\n", cus);
    }
    if (grid < 0) return;
    Args a{};
    for (int i = 0; i < 23; ++i) a.in[i] = (const float*)d_in[i];
    a.out = (float*)d_out; a.ws = (unsigned char*)d_ws;
#if N_LAUNCHES == 1
    a.ph_lo = 0; a.ph_hi = 8;
    void* kargs[] = {&a};
    hipError_t e = hipLaunchCooperativeKernel((const void*)fwd, dim3(grid), dim3(NWAVES * 64), kargs, LDS_BYTES, stream);
    if (e != hipSuccess) fprintf(stderr, "kernel_launch: cooperative launch failed: %s\n", hipGetErrorString(e));
#else
    for (int p = 0; p < 8; ++p) { a.ph_lo = p; a.ph_hi = p + 1; hipLaunchKernelGGL(fwd, dim3(grid), dim3(NWAVES * 64), LDS_BYTES, stream, a); }
#endif
}
```

```cpp
#include <hip/hip_runtime.h>
#include <hip/hip_cooperative_groups.h>
#include <cstdio>
#include <cstdint>
#ifndef N_LAUNCHES
#define N_LAUNCHES 1
#endif
#define FAST_ML 1
#define FAST_S5 1
namespace pg8 {
#define PG8_LAS __attribute__((address_space(3)))
typedef unsigned short bf16_t;
typedef short bf16x8 __attribute__((ext_vector_type(8)));
typedef float f32x4 __attribute__((ext_vector_type(4)));
typedef unsigned u32x4 __attribute__((ext_vector_type(4)));
constexpr int BM = 256, BK = 64, HALF = 128, HTB = HALF * BK * 2  , STAGE_BYTES = 8 * HTB, NXCD = 8, WGM = 8;

__host__ __device__ __forceinline__ int lds_byte(int r, int c) { const int st = (r >> 4) * 2 + (c >> 5), rr = r & 15, cc = c & 31, ob = rr * 64 + cc * 2; return st * 1024 + (ob ^ (((ob >> 9) & 1) << 5)); }
__host__ __device__ __forceinline__ void stage_rc(int b, int& R, int& C) { const int st = b / 1024, sb = b % 1024, swz = sb ^ (((sb >> 9) & 1) << 5); R = (st >> 1) * 16 + swz / 64; C = (st & 1) * 32 + (swz % 64) / 2; }
__host__ __device__ __forceinline__ int perm32(int rho) { const int n = rho >> 4, i = rho & 15; return 8 * (i >> 2) + 4 * n + (i & 3); }

struct Unit { int pm, pn; };
struct Gemm { const bf16_t* A; const bf16_t* Bt; int M, N, K; };

struct StaticOrder {
    int nM, nN, nwg, G, c;
    __host__ __device__ void init(int M, int N, int G_, int c_) { nM = M / BM; nN = N / BM; nwg = nM * nN; G = G_; c = c_; }
    __host__ __device__ bool next(int i, Unit& u) const {
        const long L = (long)i * G + c; if (L >= nwg) return false;
        int wgid = (int)L; { const int q = nwg / NXCD, r = nwg % NXCD, xcd = wgid % NXCD, off = wgid / NXCD; wgid = (xcd < r ? xcd * (q + 1) : r * (q + 1) + (xcd - r) * q) + off; }
        const int nig = WGM * nN, gid = wgid / nig, fm = gid * WGM, gsz = (nM - fm) < WGM ? (nM - fm) : WGM;
        u.pm = fm + ((wgid % nig) % gsz); u.pn = (wgid % nig) / gsz; return true;
    }
    __device__ __forceinline__ void a_ready(const Unit&) const {}
    __device__ __forceinline__ void done(const Unit&) const {}
};

__device__ __forceinline__ unsigned cvt_pk_bf16(float lo, float hi) { unsigned r; asm volatile("v_cvt_pk_bf16_f32 %0, %1, %2" : "=v"(r) : "v"(lo), "v"(hi)); return r; }
typedef float f32x2 __attribute__((ext_vector_type(2)));
__device__ __forceinline__ f32x2 gelu_pk(f32x2 v) {
    const f32x2 av = __builtin_elementwise_abs(v), d = av * 0.2316418882f + 1.0f;
    f32x2 t; t.x = __builtin_amdgcn_rcpf(d.x); t.y = __builtin_amdgcn_rcpf(d.y);
    f32x2 q = t * 0.5307027145f + (-0.7265760135f); q = q * t + 0.7107068705f; q = q * t + (-0.142248368f); q = q * t + 0.127414796f; q = q * t;
    const f32x2 s = (v * v) * (-0.72134752044f);
    f32x2 e; e.x = __builtin_amdgcn_exp2f(s.x); e.y = __builtin_amdgcn_exp2f(s.y);
    const f32x2 m = v * (q * e), r = v - m;
    f32x2 o; o.x = v.x < 0.f ? m.x : r.x; o.y = v.y < 0.f ? m.y : r.y; return o;
}

template <int ACT  > struct EpiBf16 {
    static constexpr bool PERM = true, AFTER_DRAIN = false; static_assert(ACT == 0 || ACT == 1, "EpiBf16: ACT is 0 (none) or 1 (gelu_pk)");
    bf16_t* O; int ldc; const float* bias; int split_cols; size_t split_stride; float scale0;
    __device__ __forceinline__ void operator()(const f32x4 (&acc)[2][2][4][2], const Unit& u, int wr, int wc, int fr, int fq) const {
        const int row0 = u.pm * BM + wr * 64 + fr; int colt = u.pn * BM; bf16_t* base = O;
        float sc = 1.f; if (split_cols) { const int t = colt / split_cols; base += (size_t)t * split_stride; colt -= t * split_cols; if (t == 0) sc = scale0; }
        const int col0 = colt + wc * 32 + 8 * fq, bcol0 = u.pn * BM + wc * 32 + 8 * fq;
        f32x4 bv[2][2];
#pragma unroll
        for (int bj = 0; bj < 2; ++bj)
#pragma unroll
            for (int n = 0; n < 2; ++n) bv[bj][n] = bias ? *(const f32x4*)(bias + bcol0 + bj * HALF + 4 * n) : (f32x4){0.f, 0.f, 0.f, 0.f};
#pragma unroll
        for (int ai = 0; ai < 2; ++ai)
#pragma unroll
            for (int m = 0; m < 4; ++m) { bf16_t* rowp = base + (size_t)(row0 + ai * HALF + m * 16) * ldc + col0;
#pragma unroll
                for (int bj = 0; bj < 2; ++bj) { f32x4 v0 = acc[ai][bj][m][0] + bv[bj][0], v1 = acc[ai][bj][m][1] + bv[bj][1];
                    if (ACT == 1) { f32x2 a = gelu_pk((f32x2){v0[0], v0[1]}), b = gelu_pk((f32x2){v0[2], v0[3]}), c = gelu_pk((f32x2){v1[0], v1[1]}), d = gelu_pk((f32x2){v1[2], v1[3]});
                        v0 = (f32x4){a.x, a.y, b.x, b.y}; v1 = (f32x4){c.x, c.y, d.x, d.y}; }
                    v0 = v0 * sc; v1 = v1 * sc; u32x4 w; w.x = cvt_pk_bf16(v0[0], v0[1]); w.y = cvt_pk_bf16(v0[2], v0[3]); w.z = cvt_pk_bf16(v1[0], v1[1]); w.w = cvt_pk_bf16(v1[2], v1[3]);
                    *(u32x4*)(rowp + bj * HALF) = w; } }
    }
};
template <class Epi, class Sched, bool ALIGN_EPI = false, bool SP2 = false>
__device__ __forceinline__ void gemm_phase(PG8_LAS unsigned char* lds, const Gemm g, const Sched& S, const Epi& E, const int tid) {
    const int wid = __builtin_amdgcn_readfirstlane(tid >> 6), lane = tid & 63, wr = wid >> 2, wc = wid & 3, fr = lane & 15, fq = lane >> 4;
    const int K = g.K, nt = K / BK;
    unsigned voffA[2], voffB[2];
#pragma unroll
    for (int i = 0; i < 2; ++i) { int R, C; stage_rc(tid * 16 + i * 8192, R, C); const int Rb = Epi::PERM ? ((R & ~31) + perm32(R & 31)) : R;
        voffA[i] = (unsigned)(R * K + C) * 2u; voffB[i] = (unsigned)(Rb * K + C) * 2u; }
    const size_t kstep = (size_t)(BK * 2);
    const size_t hstep = (size_t)HALF * K * 2;
    const size_t tstep = 2 * hstep;
    const unsigned ldsw = (unsigned)wid * 1024u;
    const int aoff = lds_byte(wr * 64 + fr, fq * 8), boff = lds_byte(wc * 32 + fr, fq * 8);
#define PG8_SA(b, h) (((b) * 2 + (h)) * HTB)
#define PG8_SB(b, h) ((4 + (b) * 2 + (h)) * HTB)
#define PG8_STAGE(bufoff, gbase, voff) do { _Pragma("unroll") for (int _i = 0; _i < 2; ++_i) \
        __builtin_amdgcn_global_load_lds((const unsigned*)((const char*)(gbase) + (voff)[_i]), (PG8_LAS unsigned*)(lds + (bufoff) + ldsw + _i * 8192), 16, 0, 0); } while (0)
#define PG8_LDA(dst, b, h) do { _Pragma("unroll") for (int m = 0; m < 4; ++m) _Pragma("unroll") for (int k = 0; k < 2; ++k) dst[m][k] = *(const PG8_LAS bf16x8*)(lds + PG8_SA(b, h) + aoff + m * 2048 + k * 1024); } while (0)
#define PG8_LDB(dst, b, h) do { _Pragma("unroll") for (int n = 0; n < 2; ++n) _Pragma("unroll") for (int k = 0; k < 2; ++k) dst[n][k] = *(const PG8_LAS bf16x8*)(lds + PG8_SB(b, h) + boff + n * 2048 + k * 1024); } while (0)
#define PG8_MMA(ai, bj, At, Bt) do { __builtin_amdgcn_s_setprio(1); _Pragma("unroll") for (int m = 0; m < 4; ++m) _Pragma("unroll") for (int n = 0; n < 2; ++n) _Pragma("unroll") for (int k = 0; k < 2; ++k) \
        acc[ai][bj][m][n] = __builtin_amdgcn_mfma_f32_16x16x32_bf16(Bt[n][k], At[m][k], acc[ai][bj][m][n], 0, 0, 0); __builtin_amdgcn_s_setprio(0); } while (0)
#define PG8_WAIT_V(n) asm volatile("s_waitcnt vmcnt(" #n ")" ::: "memory")
#define PG8_WAIT_L(n) asm volatile("s_waitcnt lgkmcnt(" #n ")" ::: "memory")
#define PG8_BAR __builtin_amdgcn_s_barrier()
#define PG8_SCHED __builtin_amdgcn_sched_barrier(0)
    Unit cur, nxt; int ui = 0;
    if (!S.next(0, cur)) return;
    f32x4 acc[2][2][4][2];
#pragma unroll
    for (int a = 0; a < 2; ++a)
#pragma unroll
        for (int b = 0; b < 2; ++b)
#pragma unroll
            for (int m = 0; m < 4; ++m)
#pragma unroll
                for (int n = 0; n < 2; ++n) acc[a][b][m][n] = (f32x4){0.f, 0.f, 0.f, 0.f};
    bf16x8 At[4][2], B0[2][2], B1[2][2];
    const char* cA = (const char*)g.A + (size_t)cur.pm * tstep; const char* cB = (const char*)g.Bt + (size_t)cur.pn * tstep;
    S.a_ready(cur);
    if constexpr (SP2) {
        PG8_STAGE(PG8_SB(0, 0), cB, voffB); PG8_STAGE(PG8_SB(0, 1), cB + hstep, voffB); PG8_STAGE(PG8_SA(0, 0), cA, voffA); PG8_STAGE(PG8_SA(0, 1), cA + hstep, voffA);
        if (wr == 1) PG8_BAR;
        PG8_WAIT_V(2); PG8_BAR;
        PG8_STAGE(PG8_SB(1, 0), cB + kstep, voffB); PG8_STAGE(PG8_SA(1, 0), cA + kstep, voffA); PG8_STAGE(PG8_SB(1, 1), cB + hstep + kstep, voffB);
        PG8_WAIT_V(6); PG8_BAR;
    } else {
        PG8_STAGE(PG8_SB(0, 0), cB, voffB); PG8_STAGE(PG8_SA(0, 0), cA, voffA); PG8_STAGE(PG8_SB(0, 1), cB + hstep, voffB); PG8_STAGE(PG8_SA(0, 1), cA + hstep, voffA);
        if (wr == 1) PG8_BAR;
        PG8_WAIT_V(4); PG8_BAR;
        PG8_STAGE(PG8_SB(1, 0), cB + kstep, voffB); PG8_STAGE(PG8_SA(1, 0), cA + kstep, voffA); PG8_STAGE(PG8_SB(1, 1), cB + hstep + kstep, voffB);
        PG8_WAIT_V(6); PG8_BAR;
    }
    for (;;) {
        const bool has_next = S.next(ui + 1, nxt);
        const char* nA = has_next ? (const char*)g.A + (size_t)nxt.pm * tstep : cA; const char* nB = has_next ? (const char*)g.Bt + (size_t)nxt.pn * tstep : cB;
        for (int t = 0; t < nt; t += 2) {
            const bool last = (t == nt - 2);
            const char* a1 = cA + (size_t)(t + 1) * kstep;
            const char* a2 = last ? nA : cA + (size_t)(t + 2) * kstep; const char* b2 = last ? nB : cB + (size_t)(t + 2) * kstep;
            const char* a3 = a2 + kstep; const char* b3 = b2 + kstep;
            if (last && has_next) S.a_ready(nxt);
            if constexpr (SP2) {
            PG8_LDB(B0, 0, 0); PG8_LDB(B1, 0, 1); PG8_SCHED; PG8_LDA(At, 0, 0); PG8_STAGE(PG8_SA(1, 1), a1 + hstep, voffA);
            PG8_WAIT_V(8); PG8_WAIT_L(0); PG8_BAR; PG8_MMA(0, 0, At, B0); PG8_MMA(0, 1, At, B1); PG8_BAR; PG8_SCHED;
            PG8_LDA(At, 0, 1); PG8_STAGE(PG8_SB(0, 0), b2, voffB); PG8_STAGE(PG8_SB(0, 1), b2 + hstep, voffB); PG8_STAGE(PG8_SA(0, 0), a2, voffA);
            PG8_WAIT_V(8); PG8_WAIT_L(0); PG8_BAR; PG8_MMA(1, 0, At, B0); PG8_MMA(1, 1, At, B1); PG8_BAR; PG8_SCHED;
            PG8_LDB(B0, 1, 0); PG8_LDB(B1, 1, 1); PG8_SCHED; PG8_LDA(At, 1, 0); PG8_STAGE(PG8_SA(0, 1), a2 + hstep, voffA);
            PG8_WAIT_V(8); PG8_WAIT_L(0); PG8_BAR; PG8_MMA(0, 0, At, B0); PG8_MMA(0, 1, At, B1); PG8_BAR; PG8_SCHED;
            PG8_LDA(At, 1, 1); PG8_STAGE(PG8_SB(1, 0), b3, voffB); PG8_STAGE(PG8_SB(1, 1), b3 + hstep, voffB); PG8_STAGE(PG8_SA(1, 0), a3, voffA);
            PG8_WAIT_V(8); PG8_WAIT_L(0); PG8_BAR; PG8_MMA(1, 0, At, B0); PG8_MMA(1, 1, At, B1); PG8_BAR; PG8_SCHED;
            } else {
            PG8_LDB(B0, 0, 0); PG8_SCHED; PG8_LDA(At, 0, 0); PG8_STAGE(PG8_SA(1, 1), a1 + hstep, voffA);
            PG8_WAIT_L(8); PG8_BAR; PG8_WAIT_L(0); PG8_MMA(0, 0, At, B0); PG8_BAR; PG8_SCHED;
            PG8_LDB(B1, 0, 1); PG8_STAGE(PG8_SB(0, 0), b2, voffB);
            PG8_BAR; PG8_WAIT_L(0); PG8_MMA(0, 1, At, B1); PG8_BAR;
            PG8_LDA(At, 0, 1); PG8_STAGE(PG8_SA(0, 0), a2, voffA);
            PG8_BAR; PG8_WAIT_L(0); PG8_MMA(1, 0, At, B0); PG8_BAR; PG8_SCHED;
            PG8_STAGE(PG8_SB(0, 1), b2 + hstep, voffB);
            PG8_WAIT_V(6); PG8_BAR; PG8_MMA(1, 1, At, B1); PG8_BAR;
            PG8_LDB(B0, 1, 0); PG8_SCHED; PG8_LDA(At, 1, 0); PG8_STAGE(PG8_SA(0, 1), a2 + hstep, voffA);
            PG8_WAIT_L(8); PG8_BAR; PG8_WAIT_L(0); PG8_MMA(0, 0, At, B0); PG8_BAR; PG8_SCHED;
            PG8_LDB(B1, 1, 1); PG8_STAGE(PG8_SB(1, 0), b3, voffB);
            PG8_BAR; PG8_WAIT_L(0); PG8_MMA(0, 1, At, B1); PG8_BAR;
            PG8_LDA(At, 1, 1); PG8_STAGE(PG8_SA(1, 0), a3, voffA);
            PG8_BAR; PG8_WAIT_L(0); PG8_MMA(1, 0, At, B0); PG8_BAR; PG8_SCHED;
            PG8_STAGE(PG8_SB(1, 1), b3 + hstep, voffB);
            PG8_WAIT_V(6); PG8_BAR; PG8_MMA(1, 1, At, B1); PG8_BAR;
            }
        }
        if constexpr (ALIGN_EPI) { if (wr == 0) PG8_BAR; }
        if constexpr (!Epi::AFTER_DRAIN) { E(acc, cur, wr, wc, fr, fq); S.done(cur); }
        if (!has_next) break;
#pragma unroll
        for (int a = 0; a < 2; ++a)
#pragma unroll
            for (int b = 0; b < 2; ++b)
#pragma unroll
                for (int m = 0; m < 4; ++m)
#pragma unroll
                    for (int n = 0; n < 2; ++n) acc[a][b][m][n] = (f32x4){0.f, 0.f, 0.f, 0.f};
        cur = nxt; cA = nA; cB = nB; ++ui;
        if constexpr (ALIGN_EPI) { if (wr == 1) PG8_BAR; }
    }
    PG8_WAIT_V(0);
    if constexpr (!ALIGN_EPI) { if (wr == 0) PG8_BAR; }
    PG8_BAR;
    if constexpr (Epi::AFTER_DRAIN) { E.fused(acc, cur, wr, wc, fr, fq, lds, wid, lane); S.done(cur); }
#undef PG8_SA
#undef PG8_SB
#undef PG8_STAGE
#undef PG8_LDA
#undef PG8_LDB
#undef PG8_MMA
#undef PG8_WAIT_V
#undef PG8_WAIT_L
#undef PG8_BAR
#undef PG8_SCHED
}
}
namespace pg8 {
template <bool PERM>
__device__ __forceinline__ void gemm_seg(PG8_LAS unsigned char* lds, const bf16_t* A, const bf16_t* Bt, const int K, const Unit cur, f32x4 (&acc)[2][2][4][2], const int tid) {
    const int wid = __builtin_amdgcn_readfirstlane(tid >> 6), lane = tid & 63, wr = wid >> 2, wc = wid & 3, fr = lane & 15, fq = lane >> 4;
    const int nt = K / BK;
    unsigned voffA[2], voffB[2];
#pragma unroll
    for (int i = 0; i < 2; ++i) { int R, C; stage_rc(tid * 16 + i * 8192, R, C); const int Rb = PERM ? ((R & ~31) + perm32(R & 31)) : R;
        voffA[i] = (unsigned)(R * K + C) * 2u; voffB[i] = (unsigned)(Rb * K + C) * 2u; }
    const size_t kstep = (size_t)(BK * 2);
    const size_t hstep = (size_t)HALF * K * 2;
    const size_t tstep = 2 * hstep;
    const unsigned ldsw = (unsigned)wid * 1024u;
    const int aoff = lds_byte(wr * 64 + fr, fq * 8), boff = lds_byte(wc * 32 + fr, fq * 8);
#define PG8_SA(b, h) (((b) * 2 + (h)) * HTB)
#define PG8_SB(b, h) ((4 + (b) * 2 + (h)) * HTB)
#define PG8_STAGE(bufoff, gbase, voff) do { _Pragma("unroll") for (int _i = 0; _i < 2; ++_i) \
        __builtin_amdgcn_global_load_lds((const unsigned*)((const char*)(gbase) + (voff)[_i]), (PG8_LAS unsigned*)(lds + (bufoff) + ldsw + _i * 8192), 16, 0, 0); } while (0)
#define PG8_LDA(dst, b, h) do { _Pragma("unroll") for (int m = 0; m < 4; ++m) _Pragma("unroll") for (int k = 0; k < 2; ++k) dst[m][k] = *(const PG8_LAS bf16x8*)(lds + PG8_SA(b, h) + aoff + m * 2048 + k * 1024); } while (0)
#define PG8_LDB(dst, b, h) do { _Pragma("unroll") for (int n = 0; n < 2; ++n) _Pragma("unroll") for (int k = 0; k < 2; ++k) dst[n][k] = *(const PG8_LAS bf16x8*)(lds + PG8_SB(b, h) + boff + n * 2048 + k * 1024); } while (0)
#define PG8_MMA(ai, bj, At, Bt_) do { __builtin_amdgcn_s_setprio(1); _Pragma("unroll") for (int m = 0; m < 4; ++m) _Pragma("unroll") for (int n = 0; n < 2; ++n) _Pragma("unroll") for (int k = 0; k < 2; ++k) \
        acc[ai][bj][m][n] = __builtin_amdgcn_mfma_f32_16x16x32_bf16(Bt_[n][k], At[m][k], acc[ai][bj][m][n], 0, 0, 0); __builtin_amdgcn_s_setprio(0); } while (0)
#define PG8_WAIT_V(n) asm volatile("s_waitcnt vmcnt(" #n ")" ::: "memory")
#define PG8_WAIT_L(n) asm volatile("s_waitcnt lgkmcnt(" #n ")" ::: "memory")
#define PG8_BAR __builtin_amdgcn_s_barrier()
#define PG8_SCHED __builtin_amdgcn_sched_barrier(0)
    bf16x8 At[4][2], B0[2][2], B1[2][2];
    const char* cA = (const char*)A + (size_t)cur.pm * tstep; const char* cB = (const char*)Bt + (size_t)cur.pn * tstep;
    PG8_STAGE(PG8_SB(0, 0), cB, voffB); PG8_STAGE(PG8_SB(0, 1), cB + hstep, voffB); PG8_STAGE(PG8_SA(0, 0), cA, voffA); PG8_STAGE(PG8_SA(0, 1), cA + hstep, voffA);
    if (wr == 1) PG8_BAR;
    PG8_WAIT_V(2); PG8_BAR;
    PG8_STAGE(PG8_SB(1, 0), cB + kstep, voffB); PG8_STAGE(PG8_SA(1, 0), cA + kstep, voffA); PG8_STAGE(PG8_SB(1, 1), cB + hstep + kstep, voffB);
    PG8_WAIT_V(6); PG8_BAR;
    for (int t = 0; t < nt; t += 2) {
        const bool last = (t == nt - 2);
        const char* a1 = cA + (size_t)(t + 1) * kstep;
        const char* a2 = last ? cA : cA + (size_t)(t + 2) * kstep; const char* b2 = last ? cB : cB + (size_t)(t + 2) * kstep;
        const char* a3 = a2 + kstep; const char* b3 = b2 + kstep;
        PG8_LDB(B0, 0, 0); PG8_LDB(B1, 0, 1); PG8_SCHED; PG8_LDA(At, 0, 0); PG8_STAGE(PG8_SA(1, 1), a1 + hstep, voffA);
        PG8_WAIT_V(8); PG8_WAIT_L(0); PG8_BAR; PG8_MMA(0, 0, At, B0); PG8_MMA(0, 1, At, B1); PG8_BAR; PG8_SCHED;
        PG8_LDA(At, 0, 1); PG8_STAGE(PG8_SB(0, 0), b2, voffB); PG8_STAGE(PG8_SB(0, 1), b2 + hstep, voffB); PG8_STAGE(PG8_SA(0, 0), a2, voffA);
        PG8_WAIT_V(8); PG8_WAIT_L(0); PG8_BAR; PG8_MMA(1, 0, At, B0); PG8_MMA(1, 1, At, B1); PG8_BAR; PG8_SCHED;
        PG8_LDB(B0, 1, 0); PG8_LDB(B1, 1, 1); PG8_SCHED; PG8_LDA(At, 1, 0); PG8_STAGE(PG8_SA(0, 1), a2 + hstep, voffA);
        PG8_WAIT_V(8); PG8_WAIT_L(0); PG8_BAR; PG8_MMA(0, 0, At, B0); PG8_MMA(0, 1, At, B1); PG8_BAR; PG8_SCHED;
        PG8_LDA(At, 1, 1); PG8_STAGE(PG8_SB(1, 0), b3, voffB); PG8_STAGE(PG8_SB(1, 1), b3 + hstep, voffB); PG8_STAGE(PG8_SA(1, 0), a3, voffA);
        PG8_WAIT_V(8); PG8_WAIT_L(0); PG8_BAR; PG8_MMA(1, 0, At, B0); PG8_MMA(1, 1, At, B1); PG8_BAR; PG8_SCHED;
    }
    PG8_WAIT_V(0);
    if (wr == 0) PG8_BAR;
    PG8_BAR;
#undef PG8_SA
#undef PG8_SB
#undef PG8_STAGE
#undef PG8_LDA
#undef PG8_LDB
#undef PG8_MMA
#undef PG8_WAIT_V
#undef PG8_WAIT_L
#undef PG8_BAR
#undef PG8_SCHED
}
}
constexpr int NB = 8, SEQ = 2048, DM = 1024, T = NB * SEQ, NH = 4, DH = 128, DML = 512, DS5 = 512, NG = 32, NP = 64, SG = 16, DFF = 2816, DIN = 2568;
constexpr int NPROJ = 2560;
constexpr float EPS = 1e-6f;
constexpr int NWAVES = 8;
constexpr int LDS_BYTES = 163840;

constexpr size_t MiB = 1u << 20;
constexpr size_t WS_CTL = 0, CTL_ZERO_BYTES = 1 * MiB;
constexpr size_t WS_W1T = 2 * MiB;
constexpr size_t WS_WGLU = 7 * MiB;
constexpr size_t WS_WOHS = 8 * MiB;
constexpr size_t WS_WOHM = 9 * MiB;
constexpr size_t WS_WGU = 10 * MiB;
constexpr size_t WS_WD = 21 * MiB;
constexpr size_t WS_TAB = 27 * MiB;
constexpr size_t WS_GT = 28 * MiB;
constexpr size_t WS_RS = 29 * MiB;
constexpr size_t WS_MST = 30 * MiB;
constexpr size_t WS_XN = 32 * MiB;
constexpr size_t WS_P = 64 * MiB;
constexpr size_t WS_G = 144 * MiB;
constexpr size_t WS_ACT = 64 * MiB;
constexpr size_t WS_HS = 160 * MiB;
constexpr size_t WS_HM = 176 * MiB;
constexpr size_t WS_CLOC = 192 * MiB;
constexpr size_t WS_END = 200 * MiB;
constexpr int TB_ABR = 0, TB_ABI = 2048, TB_A256R = 4096, TB_A256I = 6144, TB_BBR = 8192, TB_BBI = 8192 + 32768;
constexpr int RS1 = 0, RS2 = T * 2, RS3 = T * 2 + T * 4;

#define LAS __attribute__((address_space(3)))
typedef unsigned short bf16;
typedef unsigned v4u __attribute__((ext_vector_type(4)));
typedef unsigned v2u __attribute__((ext_vector_type(2)));
typedef float f32x4 __attribute__((ext_vector_type(4)));
#define LDS_WAIT() asm volatile("s_waitcnt lgkmcnt(0)" ::: "memory")
#define VM_WAIT() asm volatile("s_waitcnt vmcnt(0)" ::: "memory")
__device__ __forceinline__ unsigned f2bf(float f) { unsigned u = __builtin_bit_cast(unsigned, f); return (u + 0x7fffu + ((u >> 16) & 1u)) >> 16; }
__device__ __forceinline__ unsigned pk2(float lo, float hi) { return f2bf(lo) | (f2bf(hi) << 16); }
__device__ __forceinline__ float bf2f(unsigned short b) { return __builtin_bit_cast(float, (unsigned)b << 16); }
__device__ __forceinline__ float bflo(unsigned w) { return __builtin_bit_cast(float, w << 16); }
__device__ __forceinline__ float bfhi(unsigned w) { return __builtin_bit_cast(float, w & 0xffff0000u); }
__device__ __forceinline__ float wave_sum(float v) {
#pragma unroll
    for (int o = 1; o < 64; o <<= 1) v += __shfl_xor(v, o);
    return v;
}
__device__ __forceinline__ float sigmoidf_(float z) { return 1.0f / (1.0f + __expf(-z)); }
__device__ __forceinline__ float gelu_tanh(float y) { const float u = 0.7978845608028654f * (y + 0.044715f * y * y * y); const float e = __expf(2.0f * u); const float th = 1.0f - 2.0f / (e + 1.0f); return 0.5f * y * (1.0f + th); }

struct Args { const float* in[23]; float* out; unsigned char* ws; int ph_lo, ph_hi; };

namespace pg8 {
struct EpiGlu {
    static constexpr bool PERM = true, AFTER_DRAIN = true;
    const bf16_t* G; bf16_t* HS; const float* bias; const float* gamma; float* rs;
    __device__ __forceinline__ void fused(f32x4 (&acc)[2][2][4][2], const Unit& u, int wr, int wc, int fr, int fq, PG8_LAS unsigned char* lds, int wid, int lane) const {
        PG8_LAS float* part = (PG8_LAS float*)lds;
        const int colb = u.pn * BM + wc * 32 + 8 * fq;
#pragma unroll
        for (int ai = 0; ai < 2; ++ai)
#pragma unroll
            for (int m = 0; m < 4; ++m) {
                const int rl = ai * HALF + wr * 64 + m * 16 + fr; const size_t row = (size_t)u.pm * BM + rl; float ss = 0.f;
#pragma unroll
                for (int bj = 0; bj < 2; ++bj) {
                    const int col = colb + bj * HALF;
                    const u32x4 gv = *(const u32x4*)(G + row * 512 + col);
                    const f32x4 b0 = *(const f32x4*)(bias + col), b1 = *(const f32x4*)(bias + col + 4), g0 = *(const f32x4*)(gamma + col), g1 = *(const f32x4*)(gamma + col + 4);
                    const f32x4 z0 = acc[ai][bj][m][0] + b0, z1 = acc[ai][bj][m][1] + b1;
                    float gg[8]; gg[0] = bflo(gv.x); gg[1] = bfhi(gv.x); gg[2] = bflo(gv.y); gg[3] = bfhi(gv.y); gg[4] = bflo(gv.z); gg[5] = bfhi(gv.z); gg[6] = bflo(gv.w); gg[7] = bfhi(gv.w);
                    float o[8];
#pragma unroll
                    for (int e = 0; e < 4; ++e) { const float a = gg[e] * sigmoidf_(z0[e]); ss += a * a; o[e] = a * g0[e]; const float c = gg[4 + e] * sigmoidf_(z1[e]); ss += c * c; o[4 + e] = c * g1[e]; }
                    u32x4 w; w.x = cvt_pk_bf16(o[0], o[1]); w.y = cvt_pk_bf16(o[2], o[3]); w.z = cvt_pk_bf16(o[4], o[5]); w.w = cvt_pk_bf16(o[6], o[7]);
                    *(u32x4*)(HS + row * 512 + col) = w;
                }
                ss += __shfl_xor(ss, 16); ss += __shfl_xor(ss, 32);
                if (fq == 0) part[rl * 4 + wc] = ss;
            }
        __syncthreads();
        const int tid = wid * 64 + lane;
        if (tid < 256) rs[((size_t)u.pm * BM + tid) * 2 + u.pn] = (part[tid * 4] + part[tid * 4 + 1]) + (part[tid * 4 + 2] + part[tid * 4 + 3]);
    }
};
struct EpiRes {
    static constexpr bool PERM = false, AFTER_DRAIN = true;
    const float* base; float* out; bf16_t* ob; float* rs;
    __device__ __forceinline__ void fused(f32x4 (&acc)[2][2][4][2], const Unit& u, int wr, int wc, int fr, int fq, PG8_LAS unsigned char* lds, int wid, int lane) const {
        PG8_LAS float* part = (PG8_LAS float*)lds;
        const int col0 = u.pn * BM + wc * 32 + 4 * fq;
#pragma unroll
        for (int ai = 0; ai < 2; ++ai)
#pragma unroll
            for (int m = 0; m < 4; ++m) {
                const int rl = ai * HALF + wr * 64 + m * 16 + fr; const size_t off = ((size_t)u.pm * BM + rl) * 1024 + col0; float ss = 0.f;
#pragma unroll
                for (int bj = 0; bj < 2; ++bj)
#pragma unroll
                    for (int n = 0; n < 2; ++n) {
                        const f32x4 bs = *(const f32x4*)(base + off + bj * HALF + n * 16); const f32x4 h = bs + acc[ai][bj][m][n];
                        *(f32x4*)(out + off + bj * HALF + n * 16) = h; ss += (h[0] * h[0] + h[1] * h[1]) + (h[2] * h[2] + h[3] * h[3]);
                        if (ob) { typedef unsigned u32x2v __attribute__((ext_vector_type(2))); u32x2v w; w.x = cvt_pk_bf16(h[0], h[1]); w.y = cvt_pk_bf16(h[2], h[3]); *(u32x2v*)(ob + off + bj * HALF + n * 16) = w; }
                    }
                ss += __shfl_xor(ss, 16); ss += __shfl_xor(ss, 32);
                if (fq == 0) part[rl * 4 + wc] = ss;
            }
        __syncthreads();
        const int tid = wid * 64 + lane;
        if (tid < 256) rs[((size_t)u.pm * BM + tid) * 4 + u.pn] = (part[tid * 4] + part[tid * 4 + 1]) + (part[tid * 4 + 2] + part[tid * 4 + 3]);
    }
};
struct EpiGU {
    static constexpr bool PERM = true, AFTER_DRAIN = false;
    bf16_t* ACT; const float* rs;
    __device__ __forceinline__ void operator()(const f32x4 (&acc)[2][2][4][2], const Unit& u, int wr, int wc, int fr, int fq) const {
        const int col = u.pn * HALF + wc * 32 + 8 * fq;
#pragma unroll
        for (int ai = 0; ai < 2; ++ai)
#pragma unroll
            for (int m = 0; m < 4; ++m) {
                const size_t row = (size_t)u.pm * BM + ai * HALF + wr * 64 + m * 16 + fr;
                const f32x4 p = *(const f32x4*)(rs + row * 4); const float r = 1.0f / sqrtf(((p[0] + p[1]) + (p[2] + p[3])) * (1.0f / 1024.0f) + 1e-6f);
                float o[8];
#pragma unroll
                for (int n = 0; n < 2; ++n)
#pragma unroll
                    for (int e = 0; e < 4; ++e) { const float g = acc[ai][0][m][n][e] * r, up = acc[ai][1][m][n][e] * r; o[4 * n + e] = g * sigmoidf_(g) * up; }
                u32x4 w; w.x = cvt_pk_bf16(o[0], o[1]); w.y = cvt_pk_bf16(o[2], o[3]); w.z = cvt_pk_bf16(o[4], o[5]); w.w = cvt_pk_bf16(o[6], o[7]);
                *(u32x4*)(ACT + row * 2816 + col) = w;
            }
    }
};
}

__device__ __forceinline__ void p0_transpose_item(const float* W, int ldw, int k0, int csrc, bf16* WT, int ldt, int drow, const float* kscale, LAS float* scr, int lane) {
#pragma unroll 8
    for (int i = 0; i < 32; ++i) { const int kk = 2 * i + (lane >> 5); const float s = kscale ? kscale[k0 + kk] : 1.0f; scr[kk * 33 + (lane & 31)] = W[(size_t)(k0 + kk) * ldw + csrc + (lane & 31)] * s; }
    LDS_WAIT(); asm volatile("" ::: "memory");
    const int c = lane & 7;
#pragma unroll
    for (int j = 0; j < 4; ++j) { const int n = (lane >> 3) + 8 * j; const LAS float* s = scr + (8 * c) * 33 + n;
        v4u o; o.x = pk2(s[0 * 33], s[1 * 33]); o.y = pk2(s[2 * 33], s[3 * 33]); o.z = pk2(s[4 * 33], s[5 * 33]); o.w = pk2(s[6 * 33], s[7 * 33]);
        *(v4u*)(WT + (size_t)(drow + n) * ldt + k0 + 8 * c) = o; }
    LDS_WAIT(); asm volatile("" ::: "memory");
}
#define XB_TMO      128
#define XB_XCNT(j)  (256  + 64 * (j))
#define XB_XSUB(j)  (1280 + 64 * (j))
#define XB_XGEN(j)  (2304 + 64 * (j))
#define XB_TOP      3328
#define XB_TOPGEN   3392
#define XCD_BAR_WORDS 3456
#define XB_SPIN_CAP (1u << 18)

__device__ __forceinline__ unsigned xb_ld(unsigned* p)              { return __hip_atomic_load(p, __ATOMIC_RELAXED, __HIP_MEMORY_SCOPE_AGENT); }
__device__ __forceinline__ unsigned xb_add(unsigned* p, unsigned v) { return __hip_atomic_fetch_add(p, v, __ATOMIC_RELAXED, __HIP_MEMORY_SCOPE_AGENT); }
__device__ __forceinline__ unsigned xb_xcc_id() { return (unsigned)__builtin_amdgcn_s_getreg((3 << 11) | 20) & 0xFu; }
#define XB_SPIN(cond, bar) do { unsigned _sp = 0; while (cond) { __builtin_amdgcn_s_sleep(1); \
    if ((++_sp & 255u) == 0u) { if (xb_ld(&(bar)[XB_TMO])) break; if (_sp > XB_SPIN_CAP) { atomicAdd(&(bar)[XB_TMO], 1u); break; } } } } while (0)

struct XcdBarrier {
    unsigned* bar; unsigned x;
    volatile LAS unsigned* st;
};

__device__ __forceinline__ XcdBarrier xcd_barrier_post(unsigned* bar, volatile LAS unsigned* st, const int tid) {
    XcdBarrier b; b.bar = bar; b.x = xb_xcc_id(); b.st = st;
    if (tid == 0) (void)xb_add(&bar[XB_XCNT(b.x)], 1u);
    return b;
}
__device__ __forceinline__ void xcd_barrier_complete(unsigned* bar, unsigned x, unsigned& nloc, unsigned& nx) {
    const unsigned G = gridDim.x * gridDim.y * gridDim.z;
    unsigned sum, cnt, mine, sp = 0u;
    for (;;) {
        sum = 0u; cnt = 0u; mine = 0u;
#pragma unroll
        for (unsigned j = 0; j < 16; ++j) { const unsigned c = xb_ld(&bar[XB_XCNT(j)]); sum += c; cnt += (c > 0u) ? 1u : 0u; mine = (j == x) ? c : mine; }
        if (sum == G) break;
        __builtin_amdgcn_s_sleep(1);
        if ((++sp & 255u) == 0u) { if (xb_ld(&bar[XB_TMO])) break; if (sp > XB_SPIN_CAP) { atomicAdd(&bar[XB_TMO], 1u); break; } }
    }
    nloc = mine > 0u ? mine : 1u; nx = cnt > 0u ? cnt : 1u;
}

__device__ __forceinline__ void xcd_barrier(const XcdBarrier& b, const int tid) {
    asm volatile("s_waitcnt vmcnt(0)" ::: "memory");
    __syncthreads();
    if (tid == 0) {
        unsigned* bar = b.bar;
        __builtin_amdgcn_s_waitcnt(0);
        unsigned nloc = b.st[0], nx = b.st[1];
        if (nloc == 0u) { xcd_barrier_complete(bar, b.x, nloc, nx); b.st[0] = nloc; b.st[1] = nx; }
        const unsigned old = xb_add(&bar[XB_XSUB(b.x)], 1u);
        const unsigned gen = old / nloc;
        if (old + 1u == (gen + 1u) * nloc) {
            __builtin_amdgcn_fence(__ATOMIC_RELEASE, "agent");
            asm volatile("s_waitcnt vmcnt(0)" ::: "memory");
            const unsigned og = xb_add(&bar[XB_TOP], 1u);
            const unsigned tg = og / nx;
            if (og + 1u == (tg + 1u) * nx) xb_add(&bar[XB_TOPGEN], 1u);
            else XB_SPIN(xb_ld(&bar[XB_TOPGEN]) == tg, bar);
            __builtin_amdgcn_fence(__ATOMIC_ACQUIRE, "agent");
            xb_add(&bar[XB_XGEN(b.x)], 1u);
            asm volatile("s_waitcnt vmcnt(0)" ::: "memory");
        } else {
            XB_SPIN(xb_ld(&bar[XB_XGEN(b.x)]) == gen, bar);
            __builtin_amdgcn_fence(__ATOMIC_ACQUIRE, "agent");
            asm volatile("s_waitcnt vmcnt(0)" ::: "memory");
        }
    }
    __syncthreads();
}
typedef short bf16x8 __attribute__((ext_vector_type(8)));
typedef short s16x4 __attribute__((ext_vector_type(4)));
typedef float f32x16 __attribute__((ext_vector_type(16)));
typedef float f32x2_t __attribute__((ext_vector_type(2))); typedef __bf16 bf16x2_t __attribute__((ext_vector_type(2)));
__device__ __forceinline__ unsigned cvtpk(float lo, float hi) { f32x2_t v = {lo, hi}; bf16x2_t b = __builtin_convertvector(v, bf16x2_t); return __builtin_bit_cast(unsigned, b); }
#define MFMA32(a, b, c) __builtin_amdgcn_mfma_f32_32x32x16_bf16((a), (b), (c), 0, 0, 0)
__device__ __forceinline__ s16x4 tr16(const LAS bf16* p) { return __builtin_bit_cast(s16x4, __builtin_amdgcn_ds_read_tr16_b64_v4i16((LAS s16x4*)p)); }
__device__ __forceinline__ bf16x8 tr_frag(const LAS bf16* img, int ld, int krow0, int krow1, int m0, int lane) {
    const int i16 = lane & 15, q = i16 >> 2, p = i16 & 3, blk = (lane >> 4) & 1;
    const s16x4 lo = tr16(img + (krow0 + q) * ld + m0 + 16 * blk + 4 * p), hi = tr16(img + (krow1 + q) * ld + m0 + 16 * blk + 4 * p);
    return __builtin_shufflevector(lo, hi, 0, 1, 2, 3, 4, 5, 6, 7);
}
__device__ __forceinline__ int crow(int r, int hi) { return (r & 3) + 8 * (r >> 2) + 4 * hi; }
constexpr float NEG_BIG = -1e30f;
constexpr int MS_NLOC = 0, MS_MLOC = 256 * 128, MS_BTOT = MS_MLOC + 256, MS_E = MS_BTOT + 256;
constexpr size_t WS_S5B = WS_TAB + 512 * 1024;
constexpr int KLD = 136;

template <bool MAXOP> __device__ __forceinline__ float block_scan256(float v, LAS float* wt, int tid, int lane, int wave) {
#pragma unroll
    for (int o = 1; o < 64; o <<= 1) { const float n = __shfl_up(v, o); if (lane >= o) v = MAXOP ? fmaxf(v, n) : v + n; }
    if (lane == 63) wt[wave] = v;
    __syncthreads();
    float off = MAXOP ? NEG_BIG : 0.f;
    for (int w = 0; w < wave; ++w) off = MAXOP ? fmaxf(off, wt[w]) : off + wt[w];
    v = MAXOP ? fmaxf(v, off) : v + off;
    __syncthreads();
    return v;
}
__device__ __forceinline__ void conv8(const bf16* P, const float* conv, int b, int t, int chb, float (&o)[8]) {
#pragma unroll
    for (int e = 0; e < 8; ++e) o[e] = 0.f;
#pragma unroll
    for (int kk = 0; kk < 4; ++kk) { const int tt = t - 3 + kk;
        if (tt >= 0) { const v4u x = *(const v4u*)(P + ((size_t)b * SEQ + tt) * NPROJ + chb); const f32x4 w0 = *(const f32x4*)(conv + kk * 1024 + chb), w1 = *(const f32x4*)(conv + kk * 1024 + chb + 4);
            o[0] += w0[0] * bflo(x.x); o[1] += w0[1] * bfhi(x.x); o[2] += w0[2] * bflo(x.y); o[3] += w0[3] * bfhi(x.y); o[4] += w1[0] * bflo(x.z); o[5] += w1[1] * bfhi(x.z); o[6] += w1[2] * bflo(x.w); o[7] += w1[3] * bfhi(x.w); } }
#pragma unroll
    for (int e = 0; e < 8; ++e) o[e] = o[e] * sigmoidf_(o[e]);
}

__device__ __forceinline__ void mlstm_phaseA(const Args& a, LAS unsigned char* lds, int unit, int tid, int lane, int wave) {
    asm volatile("" : "+v"(tid), "+v"(lane));
    unsigned char* ws = a.ws; const bf16* P = (const bf16*)(ws + WS_P); const float* GT = (const float*)(ws + WS_GT); const float* conv = a.in[4];
    float* mst = (float*)(ws + WS_MST); bf16* CL = (bf16*)(ws + WS_CLOC);
    const int c = unit & 7, bh = unit >> 3, b = bh >> 2, h = bh & 3; const size_t row0 = (size_t)b * SEQ + 256 * c;
    LAS bf16* kL = (LAS bf16*)lds; LAS bf16* vL = (LAS bf16*)(lds + 69632); LAS float* es = (LAS float*)(lds + 139264); LAS float* wt = es + 256; LAS float* part = wt + 32;
    float li = 0.f, lf = 0.f; if (tid < 256) { li = GT[(row0 + tid) * 8 + h]; lf = GT[(row0 + tid) * 8 + 4 + h]; }
    const float bc = block_scan256<false>(lf, wt, tid, lane, wave);
    const float g = tid < 256 ? li - bc : NEG_BIG;
    const float gm = block_scan256<true>(g, wt, tid, lane, wave);
    if (tid == 255) { wt[16] = gm; wt[17] = bc; }
    __syncthreads();
    const float gmax = wt[16], btot = wt[17];
    if (tid < 256) es[tid] = __expf(g - gmax);
    __syncthreads();
#pragma unroll 2
    for (int i = 0; i < 8; ++i) { const int idx = tid + 512 * i, s = idx >> 4, ch = idx & 15;
        float o[8]; conv8(P, conv, b, 256 * c + s, 512 + h * 128 + 8 * ch, o);
        const float sc = 0.08838834764831845f * es[s];
        v4u w; w.x = cvtpk(o[0] * sc, o[1] * sc); w.y = cvtpk(o[2] * sc, o[3] * sc); w.z = cvtpk(o[4] * sc, o[5] * sc); w.w = cvtpk(o[6] * sc, o[7] * sc);
        *(LAS v4u*)(kL + s * KLD + 8 * ch) = w;
        *(LAS v4u*)(vL + s * KLD + 8 * ch) = *(const v4u*)(P + (row0 + s) * NPROJ + 1024 + h * 128 + 8 * ch); }
    __syncthreads();
    const int ti = wave >> 1, j0 = 2 * (wave & 1), hh = lane >> 5;
    f32x16 acc0, acc1;
#pragma unroll
    for (int r = 0; r < 16; ++r) { acc0[r] = 0.f; acc1[r] = 0.f; }
#pragma unroll 4
    for (int ks = 0; ks < 16; ++ks) { const int k0 = 16 * ks + 8 * hh;
        const bf16x8 af = tr_frag(kL, KLD, k0, k0 + 4, 32 * ti, lane), b0 = tr_frag(vL, KLD, k0, k0 + 4, 32 * j0, lane), b1 = tr_frag(vL, KLD, k0, k0 + 4, 32 * j0 + 32, lane);
        acc0 = MFMA32(af, b0, acc0); acc1 = MFMA32(af, b1, acc1); }
#pragma unroll
    for (int q4 = 0; q4 < 4; ++q4) { const int dk = 32 * ti + 8 * q4 + 4 * hh;
        v2u w0, w1; w0.x = cvtpk(acc0[4 * q4], acc0[4 * q4 + 1]); w0.y = cvtpk(acc0[4 * q4 + 2], acc0[4 * q4 + 3]); w1.x = cvtpk(acc1[4 * q4], acc1[4 * q4 + 1]); w1.y = cvtpk(acc1[4 * q4 + 2], acc1[4 * q4 + 3]);
        *(v2u*)(CL + ((size_t)unit * 128 + 32 * j0 + (lane & 31)) * 128 + dk) = w0; *(v2u*)(CL + ((size_t)unit * 128 + 32 * j0 + 32 + (lane & 31)) * 128 + dk) = w1; }
    { const int dk = tid & 127, qt = tid >> 7; float s = 0.f;
      for (int i = 0; i < 64; ++i) s += bf2f(kL[(qt * 64 + i) * KLD + dk]);
      part[qt * 128 + dk] = s; }
    __syncthreads();
    if (tid < 128) mst[MS_NLOC + unit * 128 + tid] = (part[tid] + part[128 + tid]) + (part[256 + tid] + part[384 + tid]);
    if (tid == 0) { mst[MS_MLOC + unit] = btot + gmax; mst[MS_BTOT + unit] = btot; }
    __syncthreads();
}

__device__ __forceinline__ void mlstm_phaseB(const Args& a, LAS unsigned char* lds, int unit, int tid, int lane, int wave) {
    asm volatile("" : "+v"(tid), "+v"(lane));
    unsigned char* ws = a.ws; const bf16* P = (const bf16*)(ws + WS_P); const float* GT = (const float*)(ws + WS_GT); const float* conv = a.in[4]; const float* gamv = a.in[5];
    const float* mst = (const float*)(ws + WS_MST); const bf16* CL = (const bf16*)(ws + WS_CLOC); bf16* HM = (bf16*)(ws + WS_HM);
    const int c = unit & 7, bh = unit >> 3, b = bh >> 2, h = bh & 3; const size_t row0 = (size_t)b * SEQ + 256 * c;
    LAS bf16* CP = (LAS bf16*)lds; LAS bf16* kL = (LAS bf16*)(lds + 34816); LAS bf16* vL = (LAS bf16*)(lds + 52224);
    LAS bf16* qL = (LAS bf16*)(lds + 75776); LAS float* gS = (LAS float*)(lds + 69632); LAS float* Ms = gS + 256; LAS float* iwS = Ms + 256; LAS float* flS = iwS + 256; LAS float* np = flS + 256; LAS float* wt = np + 128;
    float lam[8]; float mprev = NEG_BIG;
    { float run = 0.f;
#pragma unroll
      for (int j = 7; j >= 0; --j) { lam[j] = NEG_BIG; if (j < c) { lam[j] = mst[MS_MLOC + (unit - c + j)] + run; run += mst[MS_BTOT + (unit - c + j)]; mprev = fmaxf(mprev, lam[j]); } } }
    float wj[8];
#pragma unroll
    for (int j = 0; j < 8; ++j) wj[j] = (j < c) ? __expf(lam[j] - mprev) : 0.f;
    float li = 0.f, lf = 0.f; if (tid < 256) { li = GT[(row0 + tid) * 8 + h]; lf = GT[(row0 + tid) * 8 + 4 + h]; }
    const float bc = block_scan256<false>(lf, wt, tid, lane, wave);
    const float g = tid < 256 ? li - bc : NEG_BIG;
    const float cm = block_scan256<true>(g, wt, tid, lane, wave);
    if (tid < 256) { const float M = fmaxf(mprev, cm); gS[tid] = g; Ms[tid] = M; iwS[tid] = __expf(mprev - M); flS[tid] = __expf(-(bc + M)); }
#pragma unroll
    for (int i = 0; i < 4; ++i) { const int idx = tid + 512 * i, dv = idx >> 4, ch = idx & 15; float s[8];
#pragma unroll
        for (int e = 0; e < 8; ++e) s[e] = 0.f;
#pragma unroll
        for (int j = 0; j < 7; ++j) if (j < c) { const v4u x = *(const v4u*)(CL + ((size_t)(unit - c + j) * 128 + dv) * 128 + 8 * ch); const float w = wj[j];
            s[0] += w * bflo(x.x); s[1] += w * bfhi(x.x); s[2] += w * bflo(x.y); s[3] += w * bfhi(x.y); s[4] += w * bflo(x.z); s[5] += w * bfhi(x.z); s[6] += w * bflo(x.w); s[7] += w * bfhi(x.w); }
        v4u w; w.x = cvtpk(s[0], s[1]); w.y = cvtpk(s[2], s[3]); w.z = cvtpk(s[4], s[5]); w.w = cvtpk(s[6], s[7]);
        *(LAS v4u*)(CP + dv * KLD + 8 * ch) = w; }
    if (tid < 128) { float s = 0.f;
#pragma unroll
        for (int j = 0; j < 7; ++j) if (j < c) s += wj[j] * mst[MS_NLOC + (unit - c + j) * 128 + tid];
        np[tid] = s; }
#pragma unroll 1
    for (int i = 0; i < 8; ++i) { const int idx = tid + 512 * i, s = idx >> 4, ch = idx & 15;
        float o[8]; conv8(P, conv, b, 256 * c + s, h * 128 + 8 * ch, o);
        v4u w; w.x = cvtpk(o[0], o[1]); w.y = cvtpk(o[2], o[3]); w.z = cvtpk(o[4], o[5]); w.w = cvtpk(o[6], o[7]);
        *(LAS v4u*)(qL + s * KLD + 8 * ch) = w; }
    __syncthreads();
    const int tl = lane & 31, hh = lane >> 5, tq = 32 * wave + tl;
    bf16x8 qf[8]; float dotq = 0.f;
#pragma unroll
    for (int ks = 0; ks < 8; ++ks) { const v4u w = *(const LAS v4u*)(qL + tq * KLD + 16 * ks + 8 * hh); qf[ks] = __builtin_bit_cast(bf16x8, w);
        const LAS f32x4* n4 = (const LAS f32x4*)(np + 16 * ks + 8 * hh); const f32x4 na = n4[0], nb = n4[1];
        dotq += (bflo(w.x) * na[0] + bfhi(w.x) * na[1]) + (bflo(w.y) * na[2] + bfhi(w.y) * na[3]) + (bflo(w.z) * nb[0] + bfhi(w.z) * nb[1]) + (bflo(w.w) * nb[2] + bfhi(w.w) * nb[3]); }
    dotq += __shfl_xor(dotq, 32);
    const float Mt = Ms[tq], iw = iwS[tq], fl = flS[tq];
    __syncthreads();
#pragma unroll 1
    for (int i = 0; i < 8; ++i) { const int idx = tid + 512 * i, s = idx >> 4, ch = idx & 15;
        float o[8]; conv8(P, conv, b, 256 * c + s, 512 + h * 128 + 8 * ch, o);
        const float sc = 0.08838834764831845f;
        v4u w; w.x = cvtpk(o[0] * sc, o[1] * sc); w.y = cvtpk(o[2] * sc, o[3] * sc); w.z = cvtpk(o[4] * sc, o[5] * sc); w.w = cvtpk(o[6] * sc, o[7] * sc);
        *(LAS v4u*)(qL + s * KLD + 8 * ch) = w; }
    f32x16 o4[4];
#pragma unroll
    for (int j = 0; j < 4; ++j) {
#pragma unroll
        for (int r = 0; r < 16; ++r) o4[j][r] = 0.f;
#pragma unroll
        for (int ks = 0; ks < 8; ++ks) { const bf16x8 af = *(const LAS bf16x8*)(CP + (32 * j + tl) * KLD + 16 * ks + 8 * hh); o4[j] = MFMA32(af, qf[ks], o4[j]); }
#pragma unroll
        for (int r = 0; r < 16; ++r) o4[j][r] *= iw; }
    float den = 0.f;
    for (int kt = 0; kt < 4; ++kt) {
        __syncthreads();
#pragma unroll
        for (int i = 0; i < 2; ++i) { const int idx = tid + 512 * i, s = idx >> 4, ch = idx & 15;
            *(LAS v4u*)(vL + s * KLD + 8 * ch) = *(const v4u*)(P + (row0 + 64 * kt + s) * NPROJ + 1024 + h * 128 + 8 * ch); }
        __syncthreads();
#pragma unroll
        for (int st = 0; st < 2; ++st) { const int gs = 2 * kt + st;
            if (gs <= wave) {
                f32x16 sacc;
#pragma unroll
                for (int r = 0; r < 16; ++r) sacc[r] = 0.f;
#pragma unroll
                for (int ks = 0; ks < 8; ++ks) { const bf16x8 af = *(const LAS bf16x8*)(qL + (32 * gs + tl) * KLD + 16 * ks + 8 * hh); sacc = MFMA32(af, qf[ks], sacc); }
#pragma unroll
                for (int q4 = 0; q4 < 4; ++q4) { const f32x4 gv = *(const LAS f32x4*)(gS + 32 * gs + 8 * q4 + 4 * hh);
#pragma unroll
                    for (int e = 0; e < 4; ++e) { const int sl = 8 * q4 + 4 * hh + e; float w = __expf(gv[e] - Mt); if (gs == wave && sl > tl) w = 0.f; const float pv = sacc[4 * q4 + e] * w; sacc[4 * q4 + e] = pv; den += pv; } }
#pragma unroll
                for (int s2 = 0; s2 < 2; ++s2) { v4u w; w.x = cvtpk(sacc[8 * s2], sacc[8 * s2 + 1]); w.y = cvtpk(sacc[8 * s2 + 2], sacc[8 * s2 + 3]); w.z = cvtpk(sacc[8 * s2 + 4], sacc[8 * s2 + 5]); w.w = cvtpk(sacc[8 * s2 + 6], sacc[8 * s2 + 7]);
                    const bf16x8 pf = __builtin_bit_cast(bf16x8, w); const int kr = 32 * st + 16 * s2 + 4 * hh;
#pragma unroll
                    for (int j = 0; j < 4; ++j) { const bf16x8 vf = tr_frag(vL, KLD, kr, kr + 8, 32 * j, lane); o4[j] = MFMA32(vf, pf, o4[j]); } }
            } }
    }
    den += __shfl_xor(den, 32); den += iw * dotq;
    const float inv = 1.0f / fmaxf(fabsf(den), fl);
    const size_t row = row0 + tq;
    float s1 = 0.f;
#pragma unroll
    for (int j = 0; j < 4; ++j)
#pragma unroll
        for (int q4 = 0; q4 < 4; ++q4) { const int dv0 = 32 * j + 8 * q4 + 4 * hh; const v2u ov = *(const v2u*)(P + row * NPROJ + 1536 + h * 128 + dv0);
            const float og0 = sigmoidf_(bflo(ov.x)), og1 = sigmoidf_(bfhi(ov.x)), og2 = sigmoidf_(bflo(ov.y)), og3 = sigmoidf_(bfhi(ov.y));
            o4[j][4 * q4] *= og0 * inv; o4[j][4 * q4 + 1] *= og1 * inv; o4[j][4 * q4 + 2] *= og2 * inv; o4[j][4 * q4 + 3] *= og3 * inv;
            s1 += (o4[j][4 * q4] + o4[j][4 * q4 + 1]) + (o4[j][4 * q4 + 2] + o4[j][4 * q4 + 3]); if (q4 & 1) asm volatile("" ::: "memory"); }
    s1 += __shfl_xor(s1, 32); const float mu = s1 * (1.0f / 128.0f); float s2 = 0.f;
#pragma unroll
    for (int j = 0; j < 4; ++j)
#pragma unroll
        for (int r = 0; r < 16; ++r) { const float d = o4[j][r] - mu; o4[j][r] = d; s2 += d * d; }
    s2 += __shfl_xor(s2, 32); const float rstd = 1.0f / sqrtf(s2 * (1.0f / 128.0f) + EPS);
#pragma unroll
    for (int j = 0; j < 4; ++j)
#pragma unroll
        for (int q4 = 0; q4 < 4; ++q4) { const int dv0 = 32 * j + 8 * q4 + 4 * hh; const f32x4 gm = *(const f32x4*)(gamv + h * 128 + dv0);
            v2u w; w.x = cvtpk(o4[j][4 * q4] * rstd * gm[0], o4[j][4 * q4 + 1] * rstd * gm[1]); w.y = cvtpk(o4[j][4 * q4 + 2] * rstd * gm[2], o4[j][4 * q4 + 3] * rstd * gm[3]);
            *(v2u*)(HM + row * 512 + h * 128 + dv0) = w; if (q4 & 1) asm volatile("" ::: "memory"); }
    __syncthreads();
}

template <bool WITH_OUT> __device__ __forceinline__ void s5_unit(const Args& a, LAS unsigned char* lds, int id, int lane, int wave) {
    asm volatile("" : "+v"(lane));
    unsigned char* ws = a.ws; const bf16* P = (const bf16*)(ws + WS_P); const float* tab = (const float*)(ws + WS_TAB); float* mst = (float*)(ws + WS_MST);
    const bf16* BbT = (const bf16*)(ws + WS_S5B); const bf16* CmT = BbT + 32 * 128 * 16; bf16* G = (bf16*)(ws + WS_G);
    const int seg = id & 7, g = (id >> 3) & 31, b = id >> 8; const size_t row0 = (size_t)b * SEQ + 256 * seg;
    const int cl = lane & 31, hh = lane >> 5;
    const float ar0 = tab[TB_ABR + g * 64 + cl], ai0 = tab[TB_ABI + g * 64 + cl], ar1 = tab[TB_ABR + g * 64 + 32 + cl], ai1 = tab[TB_ABI + g * 64 + 32 + cl];
    bf16x8 bfr[4];
#pragma unroll
    for (int tt = 0; tt < 4; ++tt) bfr[tt] = *(const bf16x8*)(BbT + ((size_t)g * 128 + 32 * tt + cl) * 16 + 8 * hh);
    float xr0 = 0.f, xi0 = 0.f, xr1 = 0.f, xi1 = 0.f;
    if (WITH_OUT) {
        const float pr0 = tab[TB_A256R + g * 64 + cl], pi0 = tab[TB_A256I + g * 64 + cl], pr1 = tab[TB_A256R + g * 64 + 32 + cl], pi1 = tab[TB_A256I + g * 64 + 32 + cl];
        for (int j = 0; j < seg; ++j) { const float* E = mst + MS_E + (size_t)(id - seg + j) * 128;
            const float er0 = E[cl], er1 = E[32 + cl], ei0 = E[64 + cl], ei1 = E[96 + cl];
            const float n0r = pr0 * xr0 - pi0 * xi0 + er0, n0i = pr0 * xi0 + pi0 * xr0 + ei0, n1r = pr1 * xr1 - pi1 * xi1 + er1, n1i = pr1 * xi1 + pi1 * xr1 + ei1;
            xr0 = n0r; xi0 = n0i; xr1 = n1r; xi1 = n1i; }
    }
    LAS bf16* XL = (LAS bf16*)(lds + wave * 8704);
    bf16x8 cfr[8]; float dsk[8];
    if (WITH_OUT) {
#pragma unroll
        for (int ks = 0; ks < 8; ++ks) cfr[ks] = *(const bf16x8*)(CmT + ((size_t)g * 32 + cl) * 128 + 16 * ks + 8 * hh);
#pragma unroll
        for (int e = 0; e < 4; ++e) { dsk[e] = a.in[13][g * 16 + 4 * hh + e]; dsk[4 + e] = a.in[13][g * 16 + 8 + 4 * hh + e]; }
    }
    const int tok = 16 * ((cl >> 2) & 1) + (cl & 3) + 4 * (cl >> 3);
    for (int sc = 0; sc < 8; ++sc) {
        const size_t rs = row0 + 32 * sc;
        const bf16x8 uf = *(const bf16x8*)(P + (rs + tok) * NPROJ + 2048 + g * 16 + 8 * hh);
        f32x16 z;
#pragma unroll
        for (int r = 0; r < 16; ++r) z[r] = 0.f;
        const f32x16 br0 = MFMA32(uf, bfr[0], z), br1 = MFMA32(uf, bfr[1], z), bi0 = MFMA32(uf, bfr[2], z), bi1 = MFMA32(uf, bfr[3], z);
#pragma unroll
        for (int pass = 0; pass < 2; ++pass) {
            if (pass == 1) { xr0 = __shfl(xr0, cl); xi0 = __shfl(xi0, cl); xr1 = __shfl(xr1, cl); xi1 = __shfl(xi1, cl); }
#pragma unroll
            for (int r = 0; r < 16; ++r) {
                const float n0r = ar0 * xr0 - ai0 * xi0 + br0[r], n0i = ar0 * xi0 + ai0 * xr0 + bi0[r], n1r = ar1 * xr1 - ai1 * xi1 + br1[r], n1i = ar1 * xi1 + ai1 * xr1 + bi1[r];
                xr0 = n0r; xi0 = n0i; xr1 = n1r; xi1 = n1i;
                if (WITH_OUT) { if (hh == pass) { v2u w; w.x = cvtpk(xr0, xr1); w.y = cvtpk(xi0, xi1); *(LAS v2u*)(XL + (16 * hh + r) * KLD + 4 * cl) = w; } }
            }
        }
        xr0 = __shfl(xr0, 32 + cl); xi0 = __shfl(xi0, 32 + cl); xr1 = __shfl(xr1, 32 + cl); xi1 = __shfl(xi1, 32 + cl);
        if (WITH_OUT) {
            LDS_WAIT(); asm volatile("" ::: "memory");
            f32x16 y;
#pragma unroll
            for (int r = 0; r < 16; ++r) y[r] = 0.f;
#pragma unroll
            for (int ks = 0; ks < 8; ++ks) { const bf16x8 xf = *(const LAS bf16x8*)(XL + cl * KLD + 16 * ks + 8 * hh); y = MFMA32(cfr[ks], xf, y); }
            const size_t row = rs + cl;
            const v2u u0 = *(const v2u*)(P + row * NPROJ + 2048 + g * 16 + 4 * hh), u1 = *(const v2u*)(P + row * NPROJ + 2048 + g * 16 + 8 + 4 * hh);
            const float uu[8] = {bflo(u0.x), bfhi(u0.x), bflo(u0.y), bfhi(u0.y), bflo(u1.x), bfhi(u1.x), bflo(u1.y), bfhi(u1.y)};
            float o[8];
#pragma unroll
            for (int e = 0; e < 8; ++e) o[e] = gelu_tanh(y[e] + dsk[e] * uu[e]);
            v2u w0, w1; w0.x = cvtpk(o[0], o[1]); w0.y = cvtpk(o[2], o[3]); w1.x = cvtpk(o[4], o[5]); w1.y = cvtpk(o[6], o[7]);
            *(v2u*)(G + row * 512 + g * 16 + 4 * hh) = w0; *(v2u*)(G + row * 512 + g * 16 + 8 + 4 * hh) = w1;
            LDS_WAIT(); asm volatile("" ::: "memory");
        }
    }
    if (!WITH_OUT) { if (hh == 0) { float* E = mst + MS_E + (size_t)id * 128; E[cl] = xr0; E[32 + cl] = xr1; E[64 + cl] = xi0; E[96 + cl] = xi1; } }
}
__device__ __forceinline__ void p0_prologue(const Args& a, LAS unsigned char* lds, int gw, int NGW, int wave, int lane, int tid) {
    unsigned char* ws = a.ws;
    const float* x = a.in[0]; const float* g1 = a.in[1]; const float* w_in = a.in[2]; const float* if_bias = a.in[3];
    LAS float* wg = (LAS float*)(lds + 73728);
    for (int i = tid; i < 8192; i += 512) wg[i] = w_in[(size_t)(i >> 3) * DIN + 2048 + (i & 7)];
    __syncthreads();
    LAS float* scr = (LAS float*)(lds + wave * 8448);
    constexpr int I0 = 16 * 64, I1 = 16 * 16, I2 = 8 * 16, I3 = 8 * 32, I4 = 8 * 32, I5 = 16 * 88, I6 = 16 * 88, I7 = 44 * 32;
    constexpr int NITEMS = I0 + I1 + I2 + I3 + I4 + I5 + I6 + I7;
    for (int it = gw; it < NITEMS; it += NGW) {
        int r = it;
        if (r < I0) { const int kb = r / 64, nb = r % 64; p0_transpose_item(w_in, DIN, 64 * kb, 32 * nb, (bf16*)(ws + WS_W1T), 1024, 32 * nb, nullptr, scr, lane); continue; } r -= I0;
        if (r < I1) { const int kb = r / 16, nb = r % 16; p0_transpose_item(w_in, DIN, 64 * kb, 2056 + 32 * nb, (bf16*)(ws + WS_W1T), 1024, 2048 + 32 * nb, nullptr, scr, lane); continue; } r -= I1;
        if (r < I2) { const int kb = r / 16, nb = r % 16; p0_transpose_item(a.in[14], 512, 64 * kb, 32 * nb, (bf16*)(ws + WS_WGLU), 512, 32 * nb, nullptr, scr, lane); continue; } r -= I2;
        if (r < I3) { const int kb = r / 32, nb = r % 32; p0_transpose_item(a.in[17] + (size_t)512 * 1024, 1024, 64 * kb, 32 * nb, (bf16*)(ws + WS_WOHS), 512, 32 * nb, nullptr, scr, lane); continue; } r -= I3;
        if (r < I4) { const int kb = r / 32, nb = r % 32; p0_transpose_item(a.in[17], 1024, 64 * kb, 32 * nb, (bf16*)(ws + WS_WOHM), 512, 32 * nb, nullptr, scr, lane); continue; } r -= I4;
        if (r < I5) { const int kb = r / 88, nb = r % 88, n0 = 32 * nb; p0_transpose_item(a.in[19], DFF, 64 * kb, n0, (bf16*)(ws + WS_WGU), 1024, 256 * (n0 / 128) + (n0 % 128), a.in[18], scr, lane); continue; } r -= I5;
        if (r < I6) { const int kb = r / 88, nb = r % 88, n0 = 32 * nb; p0_transpose_item(a.in[20], DFF, 64 * kb, n0, (bf16*)(ws + WS_WGU), 1024, 256 * (n0 / 128) + 128 + (n0 % 128), a.in[18], scr, lane); continue; } r -= I6;
        { const int kb = r / 32, nb = r % 32; p0_transpose_item(a.in[21], 1024, 64 * kb, 32 * nb, (bf16*)(ws + WS_WD), DFF, 32 * nb, nullptr, scr, lane); }
    }
    bf16* XN = (bf16*)(ws + WS_XN); float* GT = (float*)(ws + WS_GT);
    for (int m = gw; m < T; m += NGW) {
        const f32x4* xr = (const f32x4*)(x + (size_t)m * DM) + lane;
        f32x4 v[4]; float s = 0.f;
#pragma unroll
        for (int j = 0; j < 4; ++j) { v[j] = xr[64 * j]; s += (v[j].x * v[j].x + v[j].y * v[j].y) + (v[j].z * v[j].z + v[j].w * v[j].w); }
        const float rstd = 1.0f / sqrtf(wave_sum(s) * (1.0f / DM) + EPS);
        float ga[8];
#pragma unroll
        for (int i = 0; i < 8; ++i) ga[i] = 0.f;
        unsigned long long* o8 = (unsigned long long*)(XN + (size_t)m * DM) + lane;
#pragma unroll
        for (int j = 0; j < 4; ++j) {
            const f32x4 gv = ((const f32x4*)g1)[lane + 64 * j]; const f32x4 y = v[j] * rstd * gv;
            o8[64 * j] = (unsigned long long)pk2(y.x, y.y) | ((unsigned long long)pk2(y.z, y.w) << 32);
#pragma unroll
            for (int e = 0; e < 4; ++e) { const LAS f32x4* w4 = (const LAS f32x4*)(wg + (size_t)(4 * lane + 256 * j + e) * 8); const f32x4 wa = w4[0], wb = w4[1];
                ga[0] += y[e] * wa[0]; ga[1] += y[e] * wa[1]; ga[2] += y[e] * wa[2]; ga[3] += y[e] * wa[3]; ga[4] += y[e] * wb[0]; ga[5] += y[e] * wb[1]; ga[6] += y[e] * wb[2]; ga[7] += y[e] * wb[3]; }
        }
        float mine = 0.f;
#pragma unroll
        for (int i = 0; i < 8; ++i) { const float tsum = wave_sum(ga[i]); if (lane == i) mine = tsum; }
        if (lane < 8) { float z = mine + if_bias[lane]; if (lane >= 4) z = fminf(z, 0.f) - log1pf(__expf(-fabsf(z))); GT[(size_t)m * 8 + lane] = z; }
    }
    const int gt = gw * 64 + lane;
    if (gt < NG * NP) {
        const int g = gt >> 6;
        const double dt = exp((double)a.in[8][g]); const double ar = (double)a.in[6][gt], ai = (double)a.in[7][gt];
        float* tab = (float*)(ws + WS_TAB);
        double mag = exp(dt * ar), ang = dt * ai;
        auto sincos_d = [](double th, double& sn, double& cs) { const double twopi = 6.283185307179586476925; th -= twopi * rint(th / twopi); const double t2 = th * th; double ss = 1.0, cc = 1.0;
            for (int k = 20; k >= 1; --k) { ss = 1.0 - ss * t2 / (double)((2 * k) * (2 * k + 1)); cc = 1.0 - cc * t2 / (double)((2 * k - 1) * (2 * k)); } sn = th * ss; cs = cc; };
        double sn, cs; sincos_d(ang, sn, cs);
        const double abr = mag * cs, abi = mag * sn, den = ar * ar + ai * ai, nr = abr - 1.0;
        const double zr = (nr * ar + abi * ai) / den, zi = (abi * ar - nr * ai) / den;
        tab[TB_ABR + gt] = (float)abr; tab[TB_ABI + gt] = (float)abi;
        double sn2, cs2; sincos_d(256.0 * ang, sn2, cs2); const double mag2 = exp(256.0 * dt * ar);
        tab[TB_A256R + gt] = (float)(mag2 * cs2); tab[TB_A256I + gt] = (float)(mag2 * sn2);
        for (int h = 0; h < SG; ++h) { const double br = (double)a.in[9][(size_t)gt * SG + h], bi = (double)a.in[10][(size_t)gt * SG + h];
            tab[TB_BBR + gt * SG + h] = (float)(zr * br - zi * bi); tab[TB_BBI + gt * SG + h] = (float)(zr * bi + zi * br); }
        bf16* BbT = (bf16*)(ws + WS_S5B); bf16* CmT = BbT + 32 * 128 * 16; const int pp = gt & 63, cl = pp & 31, ph = pp >> 5;
        for (int h = 0; h < SG; ++h) { BbT[((size_t)g * 128 + 32 * ph + cl) * 16 + h] = (bf16)f2bf(tab[TB_BBR + gt * SG + h]); BbT[((size_t)g * 128 + 64 + 32 * ph + cl) * 16 + h] = (bf16)f2bf(tab[TB_BBI + gt * SG + h]);
            CmT[((size_t)g * 32 + h) * 128 + 4 * cl + ph] = (bf16)f2bf(a.in[11][(size_t)g * 1024 + h * 64 + pp]); CmT[((size_t)g * 32 + h) * 128 + 4 * cl + 2 + ph] = (bf16)f2bf(-a.in[12][(size_t)g * 1024 + h * 64 + pp]);
            CmT[((size_t)g * 32 + 16 + h) * 128 + 4 * cl + ph] = 0; CmT[((size_t)g * 32 + 16 + h) * 128 + 4 * cl + 2 + ph] = 0; }
    }
}

__device__ __forceinline__ void mlstm_slow(const Args& a, LAS unsigned char* lds, int bh, int tid, int lane, int wave) {
    unsigned char* ws = a.ws; const bf16* P = (const bf16*)(ws + WS_P); const float* GT = (const float*)(ws + WS_GT); bf16* HM = (bf16*)(ws + WS_HM);
    const float* conv = a.in[4]; const float* gamv = a.in[5];
    const int b = bh >> 2, h = bh & 3;
    LAS float* qs = (LAS float*)lds; LAS float* ks = qs + 128; LAS float* vs = ks + 128; LAS float* red = vs + 128;
    const int dv = tid >> 2, part = tid & 3;
    float C[32];
#pragma unroll
    for (int j = 0; j < 32; ++j) C[j] = 0.f;
    float nown = 0.f, mst = 0.f; const float gam = gamv[h * 128 + dv];
    for (int t = 0; t < SEQ; ++t) {
        const size_t row = (size_t)b * SEQ + t;
        if (tid < 256) { const int d = tid & 127, isk = tid >> 7, ch = isk * 512 + h * 128 + d; float acc = 0.f;
#pragma unroll
            for (int kk = 0; kk < 4; ++kk) { const int tt = t - 3 + kk; if (tt >= 0) acc += conv[kk * 1024 + ch] * bf2f(P[((size_t)b * SEQ + tt) * NPROJ + ch]); }
            acc = acc * sigmoidf_(acc); if (isk) { acc *= 0.08838834764831845f; ks[d] = acc; } else qs[d] = acc;
        } else if (tid < 384) { const int d = tid - 256; vs[d] = bf2f(P[row * NPROJ + 1024 + h * 128 + d]); }
        __syncthreads();
        const float li = GT[row * 8 + h], lf = GT[row * 8 + 4 + h];
        const float mn = fmaxf(lf + mst, li), fa = __expf(lf + mst - mn), fc = __expf(li - mn); mst = mn;
        const float vv = vs[dv] * fc; float num = 0.f;
#pragma unroll
        for (int j = 0; j < 32; ++j) { C[j] = fa * C[j] + ks[32 * part + j] * vv; num += C[j] * qs[32 * part + j]; }
        num += __shfl_xor(num, 1); num += __shfl_xor(num, 2);
        float pd = 0.f; if (tid < 128) { nown = fa * nown + fc * ks[tid]; pd = nown * qs[tid]; }
        pd = wave_sum(pd); if (lane == 0) red[wave] = pd;
        __syncthreads();
        const float den = red[0] + red[1];
        const float ht = num / fmaxf(fabsf(den), __expf(-mst));
        const float og = sigmoidf_(bf2f(P[row * NPROJ + 1536 + h * 128 + dv])); const float hmv = og * ht;
        float s1 = wave_sum(part == 0 ? hmv : 0.f); if (lane == 0) red[8 + wave] = s1;
        __syncthreads();
        float mu = 0.f;
#pragma unroll
        for (int w = 0; w < 8; ++w) mu += red[8 + w];
        mu *= (1.0f / 128.0f);
        const float dd = hmv - mu; float s2 = wave_sum(part == 0 ? dd * dd : 0.f); if (lane == 0) red[16 + wave] = s2;
        __syncthreads();
        float var = 0.f;
#pragma unroll
        for (int w = 0; w < 8; ++w) var += red[16 + w];
        var *= (1.0f / 128.0f);
        if (part == 0) HM[row * 512 + h * 128 + dv] = (bf16)f2bf(dd * (1.0f / sqrtf(var + EPS)) * gam);
    }
}
__device__ __forceinline__ void s5_slow(const Args& a, int bg, int lane) {
    unsigned char* ws = a.ws; const bf16* P = (const bf16*)(ws + WS_P); bf16* G = (bf16*)(ws + WS_G); const float* tab = (const float*)(ws + WS_TAB);
    const int b = bg >> 5, g = bg & 31, gp = g * 64 + lane;
    const float abr = tab[TB_ABR + gp], abi = tab[TB_ABI + gp];
    float bbr[16], bbi[16], cr[16], ci[16];
#pragma unroll
    for (int h = 0; h < 16; ++h) { bbr[h] = tab[TB_BBR + gp * 16 + h]; bbi[h] = tab[TB_BBI + gp * 16 + h]; cr[h] = a.in[11][(size_t)g * 1024 + h * 64 + lane]; ci[h] = a.in[12][(size_t)g * 1024 + h * 64 + lane]; }
    const float dsk = a.in[13][g * 16 + (lane & 15)];
    float xr = 0.f, xi = 0.f;
    for (int t = 0; t < SEQ; ++t) {
        const size_t row = (size_t)b * SEQ + t;
        const v4u u0 = *(const v4u*)(P + row * NPROJ + 2048 + g * 16), u1 = *(const v4u*)(P + row * NPROJ + 2048 + g * 16 + 8);
        float u[16]; u[0] = bflo(u0.x); u[1] = bfhi(u0.x); u[2] = bflo(u0.y); u[3] = bfhi(u0.y); u[4] = bflo(u0.z); u[5] = bfhi(u0.z); u[6] = bflo(u0.w); u[7] = bfhi(u0.w);
        u[8] = bflo(u1.x); u[9] = bfhi(u1.x); u[10] = bflo(u1.y); u[11] = bfhi(u1.y); u[12] = bflo(u1.z); u[13] = bfhi(u1.z); u[14] = bflo(u1.w); u[15] = bfhi(u1.w);
        float bur = 0.f, bui = 0.f;
#pragma unroll
        for (int h = 0; h < 16; ++h) { bur += bbr[h] * u[h]; bui += bbi[h] * u[h]; }
        const float nxr = abr * xr - abi * xi + bur, nxi = abr * xi + abi * xr + bui; xr = nxr; xi = nxi;
        float ymine = 0.f, ul = 0.f;
#pragma unroll
        for (int h = 0; h < 16; ++h) { const float yh = wave_sum(cr[h] * xr - ci[h] * xi); if (lane == h) { ymine = yh; ul = u[h]; } }
        if (lane < 16) G[row * 512 + g * 16 + lane] = (bf16)f2bf(gelu_tanh(ymine + dsk * ul));
    }
}

__global__ void __launch_bounds__(NWAVES * 64, 2) fwd(Args args) {
    extern __shared__ __attribute__((aligned(16))) unsigned char lds_raw[];
    LAS unsigned char* lds = (LAS unsigned char*)lds_raw;
    const int G_ = gridDim.x, bx = blockIdx.x;
    const int vcu = (G_ % 8 == 0) ? (bx % 8) * (G_ / 8) + bx / 8 : bx;
    const int NGW = G_ * NWAVES;
    const int wave = __builtin_amdgcn_readfirstlane((int)threadIdx.x >> 6);
#define PHASE_IDS const int lane = (int)__builtin_amdgcn_mbcnt_hi(~0u, __builtin_amdgcn_mbcnt_lo(~0u, 0u)), tid = wave * 64 + lane, gw = vcu * NWAVES + wave; (void)lane; (void)gw; (void)tid
    unsigned char* ws = args.ws;
    const int lo = args.ph_lo, hi = args.ph_hi;
#define IN(k) (lo <= (k) && (k) < hi)
    volatile LAS unsigned* bst = (volatile LAS unsigned*)(lds + LDS_BYTES - 64);
    XcdBarrier bar; bar.bar = (unsigned*)(ws + WS_CTL) + 4096; bar.x = 0; bar.st = bst;
    if (hi - lo > 1) { const int lane0 = (int)__builtin_amdgcn_mbcnt_hi(~0u, __builtin_amdgcn_mbcnt_lo(~0u, 0u)); const int tid0 = wave * 64 + lane0;
        if (tid0 < 2) bst[tid0] = 0u; __syncthreads(); bar = xcd_barrier_post((unsigned*)(ws + WS_CTL) + 4096, bst, tid0); }
#define SEAM(k) do { if (IN(k) && IN((k) + 1)) { if ((k) == 0) cooperative_groups::this_grid().sync(); else { const int lane_ = (int)__builtin_amdgcn_mbcnt_hi(~0u, __builtin_amdgcn_mbcnt_lo(~0u, 0u)); xcd_barrier(bar, wave * 64 + lane_); } } } while (0)
    typedef pg8::bf16_t pbf;

    if (IN(0)) { PHASE_IDS; p0_prologue(args, lds, gw, NGW, wave, lane, tid); __syncthreads(); }
    SEAM(0);
    if (IN(1)) { PHASE_IDS;
        pg8::Gemm g{(const pbf*)(ws + WS_XN), (const pbf*)(ws + WS_W1T), T, NPROJ, DM}; pg8::StaticOrder S; S.init(T, NPROJ, G_, bx);
        pg8::EpiBf16<0> E{(pbf*)(ws + WS_P), NPROJ, nullptr, 0, 0, 1.f};
        pg8::gemm_phase<pg8::EpiBf16<0>, pg8::StaticOrder, true, true>(lds, g, S, E, tid);
    }
    SEAM(1);
    if (IN(2)) { PHASE_IDS;
#if FAST_ML
        for (int u = bx; u < 256; u += G_) mlstm_phaseA(args, lds, u, tid, lane, wave);
#endif
#if FAST_S5
        for (int u = bx; u < 256; u += G_) s5_unit<false>(args, lds, u * 8 + wave, lane, wave);
#endif
    }
    SEAM(2);
    if (IN(3)) { PHASE_IDS;
#if FAST_ML
        for (int u = bx; u < 256; u += G_) mlstm_phaseB(args, lds, u, tid, lane, wave);
#else
        if (bx < 32) mlstm_slow(args, lds, bx, tid, lane, wave);
#endif
        __syncthreads();
#if FAST_S5
        for (int u = bx; u < 256; u += G_) s5_unit<true>(args, lds, u * 8 + wave, lane, wave);
#else
        if (bx >= 32 && bx < 64) s5_slow(args, (bx - 32) * 8 + wave, lane);
#endif
    }
    SEAM(3);
    if (IN(4)) { PHASE_IDS;
        pg8::Gemm g{(const pbf*)(ws + WS_G), (const pbf*)(ws + WS_WGLU), T, 512, 512}; pg8::StaticOrder S; S.init(T, 512, G_, bx);
        pg8::EpiGlu E{(const pbf*)(ws + WS_G), (pbf*)(ws + WS_HS), args.in[15], args.in[16], (float*)(ws + WS_RS) + RS1};
        pg8::gemm_phase<pg8::EpiGlu, pg8::StaticOrder, false, true>(lds, g, S, E, tid);
    }
    SEAM(4);
    if (IN(5)) { PHASE_IDS;
        pg8::StaticOrder S; S.init(T, DM, G_, bx); pg8::Unit u;
        if (S.next(0, u)) {
            pg8::f32x4 acc[2][2][4][2];
#pragma unroll
            for (int i = 0; i < 2; ++i)
#pragma unroll
                for (int j = 0; j < 2; ++j)
#pragma unroll
                    for (int m = 0; m < 4; ++m)
#pragma unroll
                        for (int n = 0; n < 2; ++n) acc[i][j][m][n] = (pg8::f32x4){0.f, 0.f, 0.f, 0.f};
            pg8::gemm_seg<false>(lds, (const pbf*)(ws + WS_HS), (const pbf*)(ws + WS_WOHS), 512, u, acc, tid);
            { const int wr = wave >> 2, fr = lane & 15; const float* rs1 = (const float*)(ws + WS_RS) + RS1;
#pragma unroll
              for (int ai = 0; ai < 2; ++ai)
#pragma unroll
                for (int m = 0; m < 4; ++m) { const size_t row = (size_t)u.pm * 256 + ai * 128 + wr * 64 + m * 16 + fr; const float r2 = 1.0f / sqrtf((rs1[row * 2] + rs1[row * 2 + 1]) * (1.0f / 512.0f) + EPS);
#pragma unroll
                    for (int bj = 0; bj < 2; ++bj)
#pragma unroll
                        for (int n = 0; n < 2; ++n) acc[ai][bj][m][n] *= r2; } }
            pg8::gemm_seg<false>(lds, (const pbf*)(ws + WS_HM), (const pbf*)(ws + WS_WOHM), 512, u, acc, tid);
            pg8::EpiRes E{args.in[0], args.out, (pbf*)(ws + WS_XN), (float*)(ws + WS_RS) + RS2};
            E.fused(acc, u, wave >> 2, wave & 3, lane & 15, lane >> 4, lds, wave, lane);
        }
    }
    SEAM(5);
    if (IN(6)) { PHASE_IDS;
        pg8::Gemm g{(const pbf*)(ws + WS_XN), (const pbf*)(ws + WS_WGU), T, 2 * DFF, DM}; pg8::StaticOrder S; S.init(T, 2 * DFF, G_, bx);
        pg8::EpiGU E{(pbf*)(ws + WS_ACT), (const float*)(ws + WS_RS) + RS2};
        pg8::gemm_phase<pg8::EpiGU, pg8::StaticOrder, true, true>(lds, g, S, E, tid);
    }
    SEAM(6);
    if (IN(7)) { PHASE_IDS;
        pg8::Gemm g{(const pbf*)(ws + WS_ACT), (const pbf*)(ws + WS_WD), T, DM, DFF}; pg8::StaticOrder S; S.init(T, DM, G_, bx);
        pg8::EpiRes E{args.out, args.out, nullptr, (float*)(ws + WS_RS) + RS3};
        pg8::gemm_phase<pg8::EpiRes, pg8::StaticOrder, false, true>(lds, g, S, E, tid);
    }
    SEAM(7);
    if (IN(8)) { PHASE_IDS;
        const float* rs3 = (const float*)(ws + WS_RS) + RS3; const float* gf = args.in[22];
        for (int m = gw; m < T; m += NGW) {
            const f32x4 p = *(const f32x4*)(rs3 + (size_t)m * 4); const float r = 1.0f / sqrtf(((p[0] + p[1]) + (p[2] + p[3])) * (1.0f / DM) + EPS);
            f32x4* o = (f32x4*)(args.out + (size_t)m * DM) + lane;
#pragma unroll
            for (int j = 0; j < 4; ++j) { const f32x4 gv = ((const f32x4*)gf)[lane + 64 * j]; o[64 * j] = o[64 * j] * r * gv; }
        }
    }
#undef IN
#undef SEAM
}

#ifndef N_LAUNCHES
#define N_LAUNCHES 8
#endif
extern "C" void kernel_launch(void* const* d_in, const int* in_sizes, int n_in, void* d_out, int out_size, void* d_ws, size_t ws_size, hipStream_t stream) {
    static int grid = 0;
    if (grid == 0) {
        if (n_in != 23 || out_size != T * DM || ws_size < WS_END) { fprintf(stderr, "kernel_launch: unexpected problem shape (n_in %d out %d ws %zu)\n", n_in, out_size, ws_size); grid = -1; return; }
        int dev = 0, cus = 0, per_cu = 0;
        if (hipGetDevice(&dev) != hipSuccess || hipDeviceGetAttribute(&cus, hipDeviceAttributeMultiprocessorCount, dev) != hipSuccess) { grid = -1; return; }
        if (hipFuncSetAttribute((const void*)fwd, hipFuncAttributeMaxDynamicSharedMemorySize, LDS_BYTES) != hipSuccess) { fprintf(stderr, "kernel_launch: hipFuncSetAttribute failed\n"); grid = -1; return; }
        if (hipOccupancyMaxActiveBlocksPerMultiprocessor(&per_cu, (const void*)fwd, NWAVES * 64, LDS_BYTES) != hipSuccess || per_cu < 1) { fprintf(stderr, "kernel_launch: occupancy query says %d blocks per CU\n", per_cu); (void)hipGetLastError(); grid = -1; return; }
        grid = cus * 1;
        if (grid != 256) fprintf(stderr, "kernel_launch: %d CUs (built for 256)\n", cus);
    }
    if (grid < 0) return;
    if (hipMemsetAsync((char*)d_ws + WS_CTL, 0, CTL_ZERO_BYTES, stream) != hipSuccess) { fprintf(stderr, "kernel_launch: hipMemsetAsync failed\n"); return; }
    Args a{};
    for (int i = 0; i < 23; ++i) a.in[i] = (const float*)d_in[i];
    a.out = (float*)d_out; a.ws = (unsigned char*)d_ws;
#if N_LAUNCHES == 1
    a.ph_lo = 0; a.ph_hi = 9;
    void* kargs[] = {&a};
    hipError_t e = hipLaunchCooperativeKernel((const void*)fwd, dim3(grid), dim3(NWAVES * 64), kargs, LDS_BYTES, stream);
    if (e != hipSuccess) fprintf(stderr, "kernel_launch: cooperative launch failed: %s\n", hipGetErrorString(e));
#else
    for (int p = 0; p < 9; ++p) { a.ph_lo = p; a.ph_hi = p + 1; hipLaunchKernelGGL(fwd, dim3(grid), dim3(NWAVES * 64), LDS_BYTES, stream, a); }
#endif
}
```
